# Optimizing an MI355X kernel written in HIP

```python
import math
import jax, jax.numpy as jnp
from jax import lax
import numpy as np

D_MODEL = 1024
BATCH = 16
SEQ = 2048
DEPTH = 4

D_MIX = D_MODEL
N_GROUPS = 4
GROUP_W = D_MIX // N_GROUPS
N_HEADS = 4
A_DK = 64
A_DV = GROUP_W // N_HEADS
B_DK = 64
B_DV = GROUP_W // N_HEADS
CONV_W = 4
CONV_CH = 2 * N_HEADS * B_DK + GROUP_W
C_D = GROUP_W // N_HEADS
Q_BLOCK = 128
D_DK = 32
D_DV = GROUP_W // N_HEADS
ROPE_BASE = 10000.0
CHUNK = 64
D_FF = 2816
EPS = 1e-6

MIX_IN_SPLITS = (
    N_HEADS * A_DK, N_HEADS * A_DK, GROUP_W, GROUP_W,
    N_HEADS * B_DK, N_HEADS * B_DK, GROUP_W, GROUP_W, N_HEADS, N_HEADS,
    N_HEADS * C_D, N_HEADS * C_D, GROUP_W,
    N_HEADS * D_DK, N_HEADS * D_DK, GROUP_W, GROUP_W,
)
N_MIX_IN = sum(MIX_IN_SPLITS)

kernel_name = "hybrid_parallel_groups_hgrn2_gdn_stickbreak_retnet_macaron"


def _split_points(sizes):
    return [int(p) for p in np.cumsum(sizes)[:-1]]


def rmsnorm(x, g):
    xf = x.astype(jnp.float32)
    y = xf * lax.rsqrt(jnp.mean(xf * xf, axis=-1, keepdims=True) + EPS)
    return (y * g.astype(jnp.float32)).astype(x.dtype)


def head_rmsnorm(o, g):
    b, t, h, d = o.shape
    return rmsnorm(o, g.reshape(h, d)).reshape(b, t, h * d)


def l2norm(x):
    return x * lax.rsqrt(jnp.sum(x * x, axis=-1, keepdims=True) + EPS)


def swiglu(h, w_in, w_out):
    gate, up = jnp.split(h @ w_in, 2, axis=-1)
    return (jax.nn.silu(gate) * up) @ w_out


def to_chunks(x):
    b, t = x.shape[:2]
    y = x.reshape((b, t // CHUNK, CHUNK) + x.shape[2:])
    return jnp.moveaxis(y, 3, 1)


def from_chunks(y):
    b, h, n, c, d = y.shape
    return jnp.moveaxis(y, 1, 3).reshape(b, n * c, h, d)


def causal_conv(x, w):
    t = x.shape[1]
    xp = jnp.pad(x, ((0, 0), (CONV_W - 1, 0), (0, 0)))
    y = xp[:, 0:t] * w[0]
    for j in range(1, CONV_W):
        y = y + xp[:, j:j + t] * w[j]
    return y


def rotary(x, pos):
    half = x.shape[-1] // 2
    inv_freq = ROPE_BASE ** (-jnp.arange(half, dtype=jnp.float32) / half)
    ang = pos.astype(jnp.float32)[:, None] * inv_freq[None, :]
    cos = jnp.cos(ang)[None, :, None, :]
    sin = jnp.sin(ang)[None, :, None, :]
    x1, x2 = x[..., :half], x[..., half:]
    return jnp.concatenate([x1 * cos - x2 * sin, x1 * sin + x2 * cos], axis=-1)


def hgrn2_mixer(q, f_logit, i, g, lb, norm_g):
    dtype = q.dtype
    b, t, _ = q.shape
    q, f_logit, i, g, lb = (a.astype(jnp.float32) for a in (q, f_logit, i, g, lb))
    f = lb + (1.0 - lb) * jax.nn.sigmoid(f_logit)
    qc = to_chunks(jax.nn.silu(q).reshape(b, t, N_HEADS, A_DK))
    kc = to_chunks((1.0 - f).reshape(b, t, N_HEADS, A_DK))
    vc = to_chunks(jax.nn.silu(i).reshape(b, t, N_HEADS, A_DV))
    bc = jnp.cumsum(to_chunks(jnp.log(f).reshape(b, t, N_HEADS, A_DK)), axis=3)
    causal = jnp.tril(jnp.ones((CHUNK, CHUNK), dtype=bool))[:, :, None]

    def step(state, inp):
        q_, k_, v_, b_ = inp
        rel = jnp.where(causal, b_[:, :, :, None, :] - b_[:, :, None, :, :], -jnp.inf)
        scores = jnp.einsum('bhtk,bhsk,bhtsk->bhts', q_, k_, jnp.exp(rel))
        o = (jnp.einsum('bhts,bhsv->bhtv', scores, v_)
             + jnp.einsum('bhtk,bhkv->bhtv', q_ * jnp.exp(b_), state))
        b_last = b_[:, :, -1:, :]
        state = (jnp.exp(b_last[:, :, 0, :, None]) * state
                 + jnp.einsum('bhsk,bhsv->bhkv', k_ * jnp.exp(b_last - b_), v_))
        return state, o

    xs = tuple(jnp.moveaxis(a, 2, 0) for a in (qc, kc, vc, bc))
    s0 = jnp.zeros((b, N_HEADS, A_DK, A_DV), jnp.float32)
    _, o = lax.scan(step, s0, xs)
    o = from_chunks(jnp.moveaxis(o, 0, 2))
    return (head_rmsnorm(o, norm_g) * jax.nn.sigmoid(g)).astype(dtype)


def gated_deltanet_mixer(q, k, v, g, a, beta_logit, conv_w, a_log, dt_bias, norm_g):
    dtype = q.dtype
    b, t, _ = q.shape
    qkv = jnp.concatenate([q, k, v], axis=-1).astype(jnp.float32)
    qkv = jax.nn.silu(causal_conv(qkv, conv_w.astype(jnp.float32)))
    q, k, v = jnp.split(qkv, [N_HEADS * B_DK, 2 * N_HEADS * B_DK], axis=-1)
    q = l2norm(q.reshape(b, t, N_HEADS, B_DK)) * B_DK ** -0.5
    k = l2norm(k.reshape(b, t, N_HEADS, B_DK))
    v = v.reshape(b, t, N_HEADS, B_DV)
    beta = jax.nn.sigmoid(beta_logit.astype(jnp.float32))
    log_alpha = -jnp.exp(a_log.astype(jnp.float32)) * jax.nn.softplus(
        a.astype(jnp.float32) + dt_bias.astype(jnp.float32))
    qc, kc, vc = to_chunks(q), to_chunks(k), to_chunks(v)
    betac = to_chunks(beta)[..., None]
    gc = jnp.cumsum(to_chunks(log_alpha), axis=3)
    tril = jnp.tril(jnp.ones((CHUNK, CHUNK), dtype=bool))
    strict = jnp.tril(jnp.ones((CHUNK, CHUNK), dtype=bool), -1)
    decay = jnp.exp(jnp.where(tril, gc[..., :, None] - gc[..., None, :], -jnp.inf))
    k_beta = kc * betac
    m = jnp.where(strict, jnp.einsum('bhnik,bhnjk->bhnij', k_beta, kc) * decay, 0.0)
    rhs = jnp.concatenate([vc * betac, k_beta * jnp.exp(gc)[..., None]], axis=-1)
    sol = lax.linalg.triangular_solve(m + jnp.eye(CHUNK, dtype=jnp.float32), rhs,
                                      left_side=True, lower=True, unit_diagonal=True)
    u, w = jnp.split(sol, [B_DV], axis=-1)
    attn = jnp.where(tril, jnp.einsum('bhnik,bhnjk->bhnij', qc, kc) * decay, 0.0)

    def step(state, inp):
        q_, k_, u_, w_, g_, a_ = inp
        v_new = u_ - jnp.einsum('bhck,bhkv->bhcv', w_, state)
        o = (jnp.einsum('bhck,bhkv->bhcv', q_ * jnp.exp(g_)[..., None], state)
             + jnp.einsum('bhij,bhjv->bhiv', a_, v_new))
        g_last = g_[..., -1:]
        state = (jnp.exp(g_last)[..., None] * state
                 + jnp.einsum('bhck,bhcv->bhkv', k_ * jnp.exp(g_last - g_)[..., None], v_new))
        return state, o

    xs = tuple(jnp.moveaxis(z, 2, 0) for z in (qc, kc, u, w, gc, attn))
    s0 = jnp.zeros((b, N_HEADS, B_DK, B_DV), jnp.float32)
    _, o = lax.scan(step, s0, xs)
    o = from_chunks(jnp.moveaxis(o, 0, 2))
    return (head_rmsnorm(o, norm_g) * jax.nn.silu(g.astype(jnp.float32))).astype(dtype)


def stick_breaking_mixer(q, k, v, norm_g):
    dtype = q.dtype
    b, t, _ = q.shape

    def heads(z):
        return z.astype(jnp.float32).reshape(b, t, N_HEADS, C_D).transpose(0, 2, 1, 3)

    qh, kh, vh = heads(q) * C_D ** -0.5, heads(k), heads(v)
    blocks = []
    for blk in range(t // Q_BLOCK):
        t0, t1 = blk * Q_BLOCK, (blk + 1) * Q_BLOCK
        z = jnp.einsum('bhtd,bhsd->bhts', qh[:, :, t0:t1], kh[:, :, :t1])
        past = jnp.arange(t0, t1)[:, None] > jnp.arange(t1)[None, :]
        log_stay = jnp.where(past, jax.nn.log_sigmoid(-z), 0.0)
        between = lax.cumsum(log_stay, axis=3, reverse=True) - log_stay
        wts = jnp.where(past, jnp.exp(jax.nn.log_sigmoid(z) + between), 0.0)
        blocks.append(jnp.einsum('bhts,bhsd->bhtd', wts, vh[:, :, :t1]))
    o = jnp.concatenate(blocks, axis=2).transpose(0, 2, 1, 3)
    return head_rmsnorm(o, norm_g).astype(dtype)


def retention_mixer(q, k, v, g, norm_g):
    dtype = q.dtype
    b, t, _ = q.shape
    pos = jnp.arange(t)
    q = rotary(q.astype(jnp.float32).reshape(b, t, N_HEADS, D_DK), pos)
    k = rotary(k.astype(jnp.float32).reshape(b, t, N_HEADS, D_DK), pos) * D_DK ** -0.5
    v = v.astype(jnp.float32).reshape(b, t, N_HEADS, D_DV)
    log_gamma = jnp.log(1.0 - 2.0 ** (-5.0 - jnp.arange(N_HEADS, dtype=jnp.float32)))
    c = jnp.arange(CHUNK, dtype=jnp.float32)
    rel = c[:, None] - c[None, :]
    intra_decay = jnp.where(rel[None] >= 0, jnp.exp(rel[None] * log_gamma[:, None, None]), 0.0)
    qc, kc, vc = to_chunks(q), to_chunks(k), to_chunks(v)
    scores = jnp.einsum('bhntk,bhnsk->bhnts', qc, kc) * intra_decay[None, :, None]
    o_intra = jnp.einsum('bhnts,bhnsv->bhntv', scores, vc)
    zeta = jnp.exp((CHUNK - 1 - c)[None, :] * log_gamma[:, None])
    xi = jnp.exp((c + 1.0)[None, :] * log_gamma[:, None])
    chunk_kv = jnp.einsum('bhnsk,bhnsv,hs->nbhkv', kc, vc, zeta)
    gamma_c = jnp.exp(CHUNK * log_gamma)[:, None, None]

    def step(state, kv):
        return gamma_c * state + kv, state

    s0 = jnp.zeros((b, N_HEADS, D_DK, D_DV), jnp.float32)
    _, prev = lax.scan(step, s0, chunk_kv)
    o_cross = jnp.einsum('bhntk,nbhkv,ht->bhntv', qc, prev, xi)
    o = from_chunks(o_intra + o_cross)
    return (head_rmsnorm(o, norm_g) * jax.nn.silu(g.astype(jnp.float32))).astype(dtype)


def setup_inputs(seed: int = 0) -> dict:
    key = jax.random.key(seed)
    ks = jax.random.split(key, 20)
    f32 = jnp.float32

    def normal(k, shape, scale):
        return jax.random.normal(k, shape, f32) * scale

    def gain(k, shape):
        return 1.0 + 0.02 * jax.random.normal(k, shape, f32)

    dt = jnp.exp(jax.random.uniform(ks[14], (DEPTH, N_HEADS), f32, math.log(1e-3), math.log(1e-1)))
    dt_bias = dt + jnp.log(-jnp.expm1(-dt))
    return {
        "x": normal(ks[0], (BATCH, SEQ, D_MODEL), 1.0),
        "ffn1_norm": gain(ks[1], (DEPTH, D_MODEL)),
        "ffn1_w_in": normal(ks[2], (DEPTH, D_MODEL, 2 * D_FF), D_MODEL ** -0.5),
        "ffn1_w_out": normal(ks[3], (DEPTH, D_FF, D_MODEL), D_FF ** -0.5),
        "mix_norm": gain(ks[4], (DEPTH, D_MODEL)),
        "mix_w_in": normal(ks[5], (DEPTH, D_MODEL, N_MIX_IN), D_MODEL ** -0.5),
        "mix_w_out": normal(ks[6], (DEPTH, D_MIX, D_MODEL), D_MIX ** -0.5),
        "ffn2_norm": gain(ks[7], (DEPTH, D_MODEL)),
        "ffn2_w_in": normal(ks[8], (DEPTH, D_MODEL, 2 * D_FF), D_MODEL ** -0.5),
        "ffn2_w_out": normal(ks[9], (DEPTH, D_FF, D_MODEL), D_FF ** -0.5),
        "hgrn_lb_logits": normal(ks[10], (DEPTH, N_HEADS * A_DK), 0.5),
        "hgrn_out_norm": gain(ks[11], (DEPTH, GROUP_W)),
        "gdn_conv_w": normal(ks[12], (DEPTH, CONV_W, CONV_CH), CONV_W ** -0.5),
        "gdn_a_log": jnp.log(jax.random.uniform(ks[13], (DEPTH, N_HEADS), f32, 1.0, 16.0)),
        "gdn_dt_bias": dt_bias,
        "gdn_out_norm": gain(ks[15], (DEPTH, GROUP_W)),
        "sb_out_norm": gain(ks[16], (DEPTH, GROUP_W)),
        "ret_out_norm": gain(ks[17], (DEPTH, GROUP_W)),
        "final_norm": gain(ks[18], (D_MODEL,)),
    }


def reference(x, ffn1_norm, ffn1_w_in, ffn1_w_out, mix_norm, mix_w_in, mix_w_out,
              ffn2_norm, ffn2_w_in, ffn2_w_out, hgrn_lb_logits, hgrn_out_norm,
              gdn_conv_w, gdn_a_log, gdn_dt_bias, gdn_out_norm, sb_out_norm,
              ret_out_norm, final_norm):
    lb_all = jnp.cumsum(jax.nn.softmax(hgrn_lb_logits.astype(jnp.float32), axis=0), axis=0)
    lb_all = lb_all - lb_all[0]
    points = _split_points(MIX_IN_SPLITS)
    for l in range(DEPTH):
        x = x + 0.5 * swiglu(rmsnorm(x, ffn1_norm[l]), ffn1_w_in[l], ffn1_w_out[l])
        h = rmsnorm(x, mix_norm[l])
        (a_q, a_f, a_i, a_g,
         b_q, b_k, b_v, b_g, b_a, b_b,
         c_q, c_k, c_v,
         d_q, d_k, d_v, d_g) = jnp.split(h @ mix_w_in[l], points, axis=-1)
        y_a = hgrn2_mixer(a_q, a_f, a_i, a_g, lb_all[l], hgrn_out_norm[l])
        y_b = gated_deltanet_mixer(b_q, b_k, b_v, b_g, b_a, b_b, gdn_conv_w[l],
                                   gdn_a_log[l], gdn_dt_bias[l], gdn_out_norm[l])
        y_c = stick_breaking_mixer(c_q, c_k, c_v, sb_out_norm[l])
        y_d = retention_mixer(d_q, d_k, d_v, d_g, ret_out_norm[l])
        y = jnp.concatenate([y_a, y_b, y_c, y_d], axis=-1)
        x = x + y @ mix_w_out[l]
        x = x + 0.5 * swiglu(rmsnorm(x, ffn2_norm[l]), ffn2_w_in[l], ffn2_w_out[l])
    return rmsnorm(x, final_norm)
```

```cpp
#include <hip/hip_runtime.h>
#include <cstdio>
#include <cstdint>

namespace pg8 {
#define PG8_LAS __attribute__((address_space(3)))
typedef unsigned short bf16_t;
typedef short bf16x8 __attribute__((ext_vector_type(8)));
typedef float f32x4 __attribute__((ext_vector_type(4)));
typedef unsigned u32x4 __attribute__((ext_vector_type(4)));
constexpr int BM = 256, BK = 64, HALF = 128, HTB = HALF * BK * 2  , STAGE_BYTES = 8 * HTB, NXCD = 8, WGM = 8;

__host__ __device__ __forceinline__ int lds_byte(int r, int c) { const int st = (r >> 4) * 2 + (c >> 5), rr = r & 15, cc = c & 31, ob = rr * 64 + cc * 2; return st * 1024 + (ob ^ (((ob >> 9) & 1) << 5)); }
__host__ __device__ __forceinline__ void stage_rc(int b, int& R, int& C) { const int st = b / 1024, sb = b % 1024, swz = sb ^ (((sb >> 9) & 1) << 5); R = (st >> 1) * 16 + swz / 64; C = (st & 1) * 32 + (swz % 64) / 2; }
__host__ __device__ __forceinline__ int perm32(int rho) { const int n = rho >> 4, i = rho & 15; return 8 * (i >> 2) + 4 * n + (i & 3); }

struct Unit { int pm, pn; };
struct Gemm { const bf16_t* A; const bf16_t* Bt; int M, N, K, lda; };

struct StaticOrder {
    int nM, nN, nwg, G, c;
    __host__ __device__ void init(int M, int N, int G_, int c_) { nM = M / BM; nN = N / BM; nwg = nM * nN; G = G_; c = c_; }
    __host__ __device__ bool next(int i, Unit& u) const {
        const long L = (long)i * G + c; if (L >= nwg) return false;
        int wgid = (int)L; { const int q = nwg / NXCD, r = nwg % NXCD, xcd = wgid % NXCD, off = wgid / NXCD; wgid = (xcd < r ? xcd * (q + 1) : r * (q + 1) + (xcd - r) * q) + off; }
        const int nig = WGM * nN, gid = wgid / nig, fm = gid * WGM, gsz = (nM - fm) < WGM ? (nM - fm) : WGM;
        u.pm = fm + ((wgid % nig) % gsz); u.pn = (wgid % nig) / gsz; return true;
    }
    __device__ __forceinline__ void a_ready(const Unit&) const {}
    __device__ __forceinline__ void done(const Unit&) const {}
};

__device__ __forceinline__ unsigned cvt_pk_bf16(float lo, float hi) { unsigned r; asm volatile("v_cvt_pk_bf16_f32 %0, %1, %2" : "=v"(r) : "v"(lo), "v"(hi)); return r; }

constexpr float RMS_EPS = 1e-6f;

__device__ __forceinline__ float row_ssq(const float* ssq, int row, int fq) {
    const f32x4 p = *(const f32x4*)(ssq + (size_t)row * 16 + 4 * fq);
    float s = (p.x + p.y) + (p.z + p.w);
    s += __shfl_xor(s, 16); s += __shfl_xor(s, 32);
    return s;
}
struct EpiSwiglu {
    static constexpr bool PERM = true, AFTER_DRAIN = false;
    bf16_t* O; int ldc; const float* ssq; float inv_k;
    __device__ __forceinline__ void operator()(const f32x4 (&acc)[2][2][4][2], const Unit& u, int wr, int wc, int fr, int fq) const {
        const int row0 = u.pm * BM + wr * 64 + fr, ch0 = u.pn * HALF + wc * 32 + 8 * fq;
#pragma unroll
        for (int ai = 0; ai < 2; ++ai)
#pragma unroll
            for (int m = 0; m < 4; ++m) {
                const int row = row0 + ai * HALF + m * 16;
                const float rstd = __builtin_amdgcn_rsqf(row_ssq(ssq, row, fq) * inv_k + RMS_EPS);
                float o[8];
#pragma unroll
                for (int n = 0; n < 2; ++n)
#pragma unroll
                    for (int i = 0; i < 4; ++i) {
                        const float g = acc[ai][0][m][n][i] * rstd, up = acc[ai][1][m][n][i] * rstd;
                        const float sg = g * __builtin_amdgcn_rcpf(1.f + __builtin_amdgcn_exp2f(-1.4426950408889634f * g));
                        o[n * 4 + i] = sg * up;
                    }
                u32x4 w; w.x = cvt_pk_bf16(o[0], o[1]); w.y = cvt_pk_bf16(o[2], o[3]); w.z = cvt_pk_bf16(o[4], o[5]); w.w = cvt_pk_bf16(o[6], o[7]);
                *(u32x4*)(O + (size_t)row * ldc + ch0) = w;
            }
    }
};
struct EpiProj {
    static constexpr bool PERM = true, AFTER_DRAIN = false;
    bf16_t* O; int ldc; const float* ssq; float inv_k;
    __device__ __forceinline__ void operator()(const f32x4 (&acc)[2][2][4][2], const Unit& u, int wr, int wc, int fr, int fq) const {
        const int row0 = u.pm * BM + wr * 64 + fr, col0 = u.pn * BM + wc * 32 + 8 * fq;
#pragma unroll
        for (int ai = 0; ai < 2; ++ai)
#pragma unroll
            for (int m = 0; m < 4; ++m) {
                const int row = row0 + ai * HALF + m * 16;
                const float rstd = __builtin_amdgcn_rsqf(row_ssq(ssq, row, fq) * inv_k + RMS_EPS);
#pragma unroll
                for (int bj = 0; bj < 2; ++bj) {
                    const f32x4 v0 = acc[ai][bj][m][0] * rstd, v1 = acc[ai][bj][m][1] * rstd;
                    u32x4 w; w.x = cvt_pk_bf16(v0[0], v0[1]); w.y = cvt_pk_bf16(v0[2], v0[3]); w.z = cvt_pk_bf16(v1[0], v1[1]); w.w = cvt_pk_bf16(v1[2], v1[3]);
                    *(u32x4*)(O + (size_t)row * ldc + col0 + bj * HALF) = w;
                }
            }
    }
};
struct EpiResid {
    static constexpr bool PERM = true, AFTER_DRAIN = false;
    const float* xin; float* xout; bf16_t* xb; float* ssq_out; int ldx; float scale;
    __device__ __forceinline__ void operator()(const f32x4 (&acc)[2][2][4][2], const Unit& u, int wr, int wc, int fr, int fq) const {
        const int row0 = u.pm * BM + wr * 64 + fr, col0 = u.pn * BM + wc * 32 + 8 * fq;
#pragma unroll
        for (int ai = 0; ai < 2; ++ai)
#pragma unroll
            for (int m = 0; m < 4; ++m) {
                const int row = row0 + ai * HALF + m * 16;
                float ss = 0.f;
#pragma unroll
                for (int bj = 0; bj < 2; ++bj) {
                    const size_t off = (size_t)row * ldx + col0 + bj * HALF;
                    const f32x4 x0 = *(const f32x4*)(xin + off), x1 = *(const f32x4*)(xin + off + 4);
                    const f32x4 v0 = x0 + acc[ai][bj][m][0] * scale, v1 = x1 + acc[ai][bj][m][1] * scale;
                    *(f32x4*)(xout + off) = v0; *(f32x4*)(xout + off + 4) = v1;
                    u32x4 w; w.x = cvt_pk_bf16(v0[0], v0[1]); w.y = cvt_pk_bf16(v0[2], v0[3]); w.z = cvt_pk_bf16(v1[0], v1[1]); w.w = cvt_pk_bf16(v1[2], v1[3]);
                    *(u32x4*)(xb + off) = w;
                    ss += (v0[0] * v0[0] + v0[1] * v0[1]) + (v0[2] * v0[2] + v0[3] * v0[3]) + (v1[0] * v1[0] + v1[1] * v1[1]) + (v1[2] * v1[2] + v1[3] * v1[3]);
                }
                ss += __shfl_xor(ss, 16); ss += __shfl_xor(ss, 32);
                if (fq == 0) ssq_out[(size_t)row * 16 + u.pn * 4 + wc] = ss;
            }
    }
};

template <class Epi, class Sched, bool ALIGN_EPI = false, bool SP2 = false>
__device__ __forceinline__ void gemm_phase(PG8_LAS unsigned char* lds, const Gemm g, const Sched& S, const Epi& E) {
    int tid_ = threadIdx.x; asm volatile("" : "+v"(tid_));
    const int tid = tid_, wid = __builtin_amdgcn_readfirstlane(tid >> 6), lane = tid & 63, wr = wid >> 2, wc = wid & 3, fr = lane & 15, fq = lane >> 4;
    const int K = g.K, nt = K / BK, lda = g.lda;
    unsigned voffA[2], voffB[2];
#pragma unroll
    for (int i = 0; i < 2; ++i) { int R, C; stage_rc(tid * 16 + i * 8192, R, C); const int Rb = Epi::PERM ? ((R & ~31) + perm32(R & 31)) : R;
        voffA[i] = (unsigned)(R * lda + C) * 2u; voffB[i] = (unsigned)(Rb * K + C) * 2u; }
    const size_t kstep = (size_t)(BK * 2);
    const size_t hstepA = (size_t)HALF * lda * 2, hstepB = (size_t)HALF * K * 2;
    const size_t tstepA = 2 * hstepA, tstepB = 2 * hstepB;
    const unsigned ldsw = (unsigned)wid * 1024u;
    const int aoff = lds_byte(wr * 64 + fr, fq * 8), boff = lds_byte(wc * 32 + fr, fq * 8);
#define PG8_SA(b, h) (((b) * 2 + (h)) * HTB)
#define PG8_SB(b, h) ((4 + (b) * 2 + (h)) * HTB)
#define PG8_STAGE(bufoff, gbase, voff) do { _Pragma("unroll") for (int _i = 0; _i < 2; ++_i) \
        __builtin_amdgcn_global_load_lds((const unsigned*)((const char*)(gbase) + (voff)[_i]), (PG8_LAS unsigned*)(lds + (bufoff) + ldsw + _i * 8192), 16, 0, 0); } while (0)
#define PG8_LDA(dst, b, h) do { _Pragma("unroll") for (int m = 0; m < 4; ++m) _Pragma("unroll") for (int k = 0; k < 2; ++k) dst[m][k] = *(const PG8_LAS bf16x8*)(lds + PG8_SA(b, h) + aoff + m * 2048 + k * 1024); } while (0)
#define PG8_LDB(dst, b, h) do { _Pragma("unroll") for (int n = 0; n < 2; ++n) _Pragma("unroll") for (int k = 0; k < 2; ++k) dst[n][k] = *(const PG8_LAS bf16x8*)(lds + PG8_SB(b, h) + boff + n * 2048 + k * 1024); } while (0)
#define PG8_MMA(ai, bj, At, Bt) do { __builtin_amdgcn_s_setprio(1); _Pragma("unroll") for (int m = 0; m < 4; ++m) _Pragma("unroll") for (int n = 0; n < 2; ++n) _Pragma("unroll") for (int k = 0; k < 2; ++k) \
        acc[ai][bj][m][n] = __builtin_amdgcn_mfma_f32_16x16x32_bf16(Bt[n][k], At[m][k], acc[ai][bj][m][n], 0, 0, 0); __builtin_amdgcn_s_setprio(0); } while (0)
#define PG8_WAIT_V(n) asm volatile("s_waitcnt vmcnt(" #n ")" ::: "memory")
#define PG8_WAIT_L(n) asm volatile("s_waitcnt lgkmcnt(" #n ")" ::: "memory")
#define PG8_BAR __builtin_amdgcn_s_barrier()
#define PG8_SCHED __builtin_amdgcn_sched_barrier(0)
    Unit cur, nxt; int ui = 0;
    if (!S.next(0, cur)) return;
    f32x4 acc[2][2][4][2];
#pragma unroll
    for (int a = 0; a < 2; ++a)
#pragma unroll
        for (int b = 0; b < 2; ++b)
#pragma unroll
            for (int m = 0; m < 4; ++m)
#pragma unroll
                for (int n = 0; n < 2; ++n) acc[a][b][m][n] = (f32x4){0.f, 0.f, 0.f, 0.f};
    bf16x8 At[4][2], B0[2][2], B1[2][2];
    const char* cA = (const char*)g.A + (size_t)cur.pm * tstepA; const char* cB = (const char*)g.Bt + (size_t)cur.pn * tstepB;
    S.a_ready(cur);
    if constexpr (SP2) {
        PG8_STAGE(PG8_SB(0, 0), cB, voffB); PG8_STAGE(PG8_SB(0, 1), cB + hstepB, voffB); PG8_STAGE(PG8_SA(0, 0), cA, voffA); PG8_STAGE(PG8_SA(0, 1), cA + hstepA, voffA);
        if (wr == 1) PG8_BAR;
        PG8_WAIT_V(2); PG8_BAR;
        PG8_STAGE(PG8_SB(1, 0), cB + kstep, voffB); PG8_STAGE(PG8_SA(1, 0), cA + kstep, voffA); PG8_STAGE(PG8_SB(1, 1), cB + hstepB + kstep, voffB);
        PG8_WAIT_V(6); PG8_BAR;
    } else {
        PG8_STAGE(PG8_SB(0, 0), cB, voffB); PG8_STAGE(PG8_SA(0, 0), cA, voffA); PG8_STAGE(PG8_SB(0, 1), cB + hstepB, voffB); PG8_STAGE(PG8_SA(0, 1), cA + hstepA, voffA);
        if (wr == 1) PG8_BAR;
        PG8_WAIT_V(4); PG8_BAR;
        PG8_STAGE(PG8_SB(1, 0), cB + kstep, voffB); PG8_STAGE(PG8_SA(1, 0), cA + kstep, voffA); PG8_STAGE(PG8_SB(1, 1), cB + hstepB + kstep, voffB);
        PG8_WAIT_V(6); PG8_BAR;
    }
    for (;;) {
        const bool has_next = S.next(ui + 1, nxt);
        const char* nA = has_next ? (const char*)g.A + (size_t)nxt.pm * tstepA : cA; const char* nB = has_next ? (const char*)g.Bt + (size_t)nxt.pn * tstepB : cB;
        for (int t = 0; t < nt; t += 2) {
            const bool last = (t == nt - 2);
            const char* a1 = cA + (size_t)(t + 1) * kstep;
            const char* a2 = last ? nA : cA + (size_t)(t + 2) * kstep; const char* b2 = last ? nB : cB + (size_t)(t + 2) * kstep;
            const char* a3 = a2 + kstep; const char* b3 = b2 + kstep;
            if (last && has_next) S.a_ready(nxt);
            if constexpr (SP2) {
            PG8_LDB(B0, 0, 0); PG8_LDB(B1, 0, 1); PG8_SCHED; PG8_LDA(At, 0, 0); PG8_STAGE(PG8_SA(1, 1), a1 + hstepA, voffA);
            PG8_WAIT_V(8); PG8_WAIT_L(0); PG8_BAR; PG8_MMA(0, 0, At, B0); PG8_MMA(0, 1, At, B1); PG8_BAR; PG8_SCHED;
            PG8_LDA(At, 0, 1); PG8_STAGE(PG8_SB(0, 0), b2, voffB); PG8_STAGE(PG8_SB(0, 1), b2 + hstepB, voffB); PG8_STAGE(PG8_SA(0, 0), a2, voffA);
            PG8_WAIT_V(8); PG8_WAIT_L(0); PG8_BAR; PG8_MMA(1, 0, At, B0); PG8_MMA(1, 1, At, B1); PG8_BAR; PG8_SCHED;
            PG8_LDB(B0, 1, 0); PG8_LDB(B1, 1, 1); PG8_SCHED; PG8_LDA(At, 1, 0); PG8_STAGE(PG8_SA(0, 1), a2 + hstepA, voffA);
            PG8_WAIT_V(8); PG8_WAIT_L(0); PG8_BAR; PG8_MMA(0, 0, At, B0); PG8_MMA(0, 1, At, B1); PG8_BAR; PG8_SCHED;
            PG8_LDA(At, 1, 1); PG8_STAGE(PG8_SB(1, 0), b3, voffB); PG8_STAGE(PG8_SB(1, 1), b3 + hstepB, voffB); PG8_STAGE(PG8_SA(1, 0), a3, voffA);
            PG8_WAIT_V(8); PG8_WAIT_L(0); PG8_BAR; PG8_MMA(1, 0, At, B0); PG8_MMA(1, 1, At, B1); PG8_BAR; PG8_SCHED;
            } else {
            PG8_LDB(B0, 0, 0); PG8_SCHED; PG8_LDA(At, 0, 0); PG8_STAGE(PG8_SA(1, 1), a1 + hstepA, voffA);
            PG8_WAIT_L(8); PG8_BAR; PG8_WAIT_L(0); PG8_MMA(0, 0, At, B0); PG8_BAR; PG8_SCHED;
            PG8_LDB(B1, 0, 1); PG8_STAGE(PG8_SB(0, 0), b2, voffB);
            PG8_BAR; PG8_WAIT_L(0); PG8_MMA(0, 1, At, B1); PG8_BAR;
            PG8_LDA(At, 0, 1); PG8_STAGE(PG8_SA(0, 0), a2, voffA);
            PG8_BAR; PG8_WAIT_L(0); PG8_MMA(1, 0, At, B0); PG8_BAR; PG8_SCHED;
            PG8_STAGE(PG8_SB(0, 1), b2 + hstepB, voffB);
            PG8_WAIT_V(6); PG8_BAR; PG8_MMA(1, 1, At, B1); PG8_BAR;
            PG8_LDB(B0, 1, 0); PG8_SCHED; PG8_LDA(At, 1, 0); PG8_STAGE(PG8_SA(0, 1), a2 + hstepA, voffA);
            PG8_WAIT_L(8); PG8_BAR; PG8_WAIT_L(0); PG8_MMA(0, 0, At, B0); PG8_BAR; PG8_SCHED;
            PG8_LDB(B1, 1, 1); PG8_STAGE(PG8_SB(1, 0), b3, voffB);
            PG8_BAR; PG8_WAIT_L(0); PG8_MMA(0, 1, At, B1); PG8_BAR;
            PG8_LDA(At, 1, 1); PG8_STAGE(PG8_SA(1, 0), a3, voffA);
            PG8_BAR; PG8_WAIT_L(0); PG8_MMA(1, 0, At, B0); PG8_BAR; PG8_SCHED;
            PG8_STAGE(PG8_SB(1, 1), b3 + hstepB, voffB);
            PG8_WAIT_V(6); PG8_BAR; PG8_MMA(1, 1, At, B1); PG8_BAR;
            }
        }
        if constexpr (ALIGN_EPI) { if (wr == 0) PG8_BAR; }
        if constexpr (!Epi::AFTER_DRAIN) { E(acc, cur, wr, wc, fr, fq); S.done(cur); }
        if (!has_next) break;
#pragma unroll
        for (int a = 0; a < 2; ++a)
#pragma unroll
            for (int b = 0; b < 2; ++b)
#pragma unroll
                for (int m = 0; m < 4; ++m)
#pragma unroll
                    for (int n = 0; n < 2; ++n) acc[a][b][m][n] = (f32x4){0.f, 0.f, 0.f, 0.f};
        cur = nxt; cA = nA; cB = nB; ++ui;
        if constexpr (ALIGN_EPI) { if (wr == 1) PG8_BAR; }
    }
    PG8_WAIT_V(0);
    if constexpr (!ALIGN_EPI) { if (wr == 0) PG8_BAR; }
    PG8_BAR;
#undef PG8_SA
#undef PG8_SB
#undef PG8_STAGE
#undef PG8_LDA
#undef PG8_LDB
#undef PG8_MMA
#undef PG8_WAIT_V
#undef PG8_WAIT_L
#undef PG8_BAR
#undef PG8_SCHED
}
}

constexpr int NWAVES = 8, NTHR = NWAVES * 64;
constexpr int BATCH = 16, SEQ = 2048, DM = 1024, DEPTH = 4, NH = 4;
constexpr int M = BATCH * SEQ;
constexpr int DFF = 2816, NFI = 2 * DFF;
constexpr int NMIX_SRC = 3592, NMIX = 3840;
constexpr int CHUNK = 64, NCHUNK = SEQ / CHUNK;
constexpr float EPS = 1e-6f;
constexpr int C_AQ = 0, C_BQ = 256, C_CQ = 512, C_DQK = 768, C_AF = 1024, C_AI = 1280, C_AG = 1536, C_BK = 1792, C_BV = 2048, C_BG = 2304,
              C_CK = 2560, C_CV = 2816, C_DV = 3072, C_DG = 3328, C_BA = 3584, C_BB = 3588;
constexpr int Y_A = 0, Y_B = 256, Y_C = 512, Y_D = 768;

constexpr size_t MiB = 1u << 20;
constexpr size_t WS_CTL = 0, CTL_ZERO_BYTES = 64 * 1024;
constexpr size_t WS_ROPE = 1 * MiB;
constexpr size_t WS_SSQ = 2 * MiB;
constexpr size_t WS_W = 4 * MiB;
constexpr size_t W_FI = (size_t)NFI * DM * 2, W_FO = (size_t)DM * DFF * 2, W_MI = (size_t)NMIX * DM * 2, W_MO = (size_t)DM * DM * 2;
constexpr size_t WL_FI1 = 0, WL_FO1 = WL_FI1 + W_FI, WL_FI2 = WL_FO1 + W_FO, WL_FO2 = WL_FI2 + W_FI, WL_MI = WL_FO2 + W_FO, WL_MO = WL_MI + W_MI, WL_BYTES = WL_MO + W_MO;
constexpr size_t WS_XB = 176 * MiB;
constexpr size_t WS_BIG = 240 * MiB;
constexpr size_t WS_END = 480 * MiB;
static_assert(WS_W + DEPTH * WL_BYTES <= WS_XB && WS_XB + (size_t)M * DM * 2 <= WS_BIG && WS_BIG + (size_t)M * NMIX * 2 <= WS_END, "d_ws map");
constexpr int CW_TMO = 0, CW_CODE = 1;
constexpr int CW_BAR = 4096;
constexpr int CW_QUEUE = 8192;
static_assert((size_t)(CW_QUEUE + 64 * DEPTH) * 4 <= CTL_ZERO_BYTES && WS_SSQ + (size_t)M * 16 * 4 <= WS_W, "CTL words inside the memset region");

constexpr int RING_OFF = 0, RING_BYTES = 131072;
constexpr int LDSCTL_OFF = RING_BYTES, MISC_OFF = LDSCTL_OFF + 320;
constexpr int LDS_BYTES = 147456;

#define GAS __attribute__((address_space(1)))
#define LAS __attribute__((address_space(3)))
typedef unsigned short bf16;
typedef unsigned v4u __attribute__((ext_vector_type(4)));
typedef float f32x4 __attribute__((ext_vector_type(4)));
typedef float f32x2 __attribute__((ext_vector_type(2)));
typedef GAS unsigned gu32;
#define RLX_AGENT __ATOMIC_RELAXED, __HIP_MEMORY_SCOPE_AGENT
#define LDS_WAIT() asm volatile("s_waitcnt lgkmcnt(0)" ::: "memory")
#define VM_WAIT() asm volatile("s_waitcnt vmcnt(0)" ::: "memory")
__device__ __forceinline__ unsigned f2bf(float f) { unsigned u = __builtin_bit_cast(unsigned, f); return (u + 0x7fffu + ((u >> 16) & 1u)) >> 16; }
__device__ __forceinline__ unsigned pk2(float lo, float hi) { return f2bf(lo) | (f2bf(hi) << 16); }
__device__ __forceinline__ float bflo(unsigned u) { return __builtin_bit_cast(float, u << 16); }
__device__ __forceinline__ float bfhi(unsigned u) { return __builtin_bit_cast(float, u & 0xffff0000u); }
__device__ __forceinline__ float fexp(float x) { return __builtin_amdgcn_exp2f(x * 1.4426950408889634f); }
__device__ __forceinline__ float fsigmoid(float x) { return __builtin_amdgcn_rcpf(1.f + fexp(-x)); }
__device__ __forceinline__ float fsilu(float x) { return x * fsigmoid(x); }

#define XB_TMO      128
#define XB_XCNT(j)  (256  + 64 * (j))
#define XB_XSUB(j)  (1280 + 64 * (j))
#define XB_XGEN(j)  (2304 + 64 * (j))
#define XB_TOP      3328
#define XB_TOPGEN   3392
#define XCD_BAR_WORDS 3456
#define XB_SPIN_CAP (1u << 20)

__device__ __forceinline__ unsigned xb_ld(unsigned* p)              { return __hip_atomic_load(p, __ATOMIC_RELAXED, __HIP_MEMORY_SCOPE_AGENT); }
__device__ __forceinline__ unsigned xb_add(unsigned* p, unsigned v) { return __hip_atomic_fetch_add(p, v, __ATOMIC_RELAXED, __HIP_MEMORY_SCOPE_AGENT); }
__device__ __forceinline__ unsigned xb_xcc_id() { return (unsigned)__builtin_amdgcn_s_getreg((3 << 11) | 20) & 0xFu; }
#define XB_SPIN(cond, bar) do { unsigned _sp = 0; while (cond) { __builtin_amdgcn_s_sleep(1); \
    if ((++_sp & 255u) == 0u) { if (xb_ld(&(bar)[XB_TMO])) break; if (_sp > XB_SPIN_CAP) { atomicAdd(&(bar)[XB_TMO], 1u); break; } } } } while (0)

struct XcdBarrier {
    unsigned* bar; unsigned x;
    volatile LAS unsigned* st;
};
__device__ __forceinline__ XcdBarrier xcd_barrier_post(unsigned* bar, volatile LAS unsigned* st) {
    XcdBarrier b; b.bar = bar; b.x = xb_xcc_id(); b.st = st;
    if (threadIdx.x == 0) (void)xb_add(&bar[XB_XCNT(b.x)], 1u);
    return b;
}
__device__ __forceinline__ void xcd_barrier_complete(unsigned* bar, unsigned x, unsigned& nloc, unsigned& nx) {
    const unsigned G = gridDim.x * gridDim.y * gridDim.z;
    unsigned sum, cnt, mine, sp = 0u;
    for (;;) {
        sum = 0u; cnt = 0u; mine = 0u;
#pragma unroll
        for (unsigned j = 0; j < 16; ++j) { const unsigned c = xb_ld(&bar[XB_XCNT(j)]); sum += c; cnt += (c > 0u) ? 1u : 0u; mine = (j == x) ? c : mine; }
        if (sum == G) break;
        __builtin_amdgcn_s_sleep(1);
        if ((++sp & 255u) == 0u) { if (xb_ld(&bar[XB_TMO])) break; if (sp > XB_SPIN_CAP) { atomicAdd(&bar[XB_TMO], 1u); break; } }
    }
    nloc = mine > 0u ? mine : 1u; nx = cnt > 0u ? cnt : 1u;
}
__device__ __forceinline__ void xcd_barrier(const XcdBarrier& b) {
    asm volatile("s_waitcnt vmcnt(0)" ::: "memory");
    __syncthreads();
    if (threadIdx.x == 0) {
        unsigned* bar = b.bar;
        __builtin_amdgcn_s_waitcnt(0);
        unsigned nloc = b.st[0], nx = b.st[1];
        if (nloc == 0u) { xcd_barrier_complete(bar, b.x, nloc, nx); b.st[0] = nloc; b.st[1] = nx; }
        const unsigned old = xb_add(&bar[XB_XSUB(b.x)], 1u);
        const unsigned gen = old / nloc;
        if (old + 1u == (gen + 1u) * nloc) {
            __builtin_amdgcn_fence(__ATOMIC_RELEASE, "agent");
            asm volatile("s_waitcnt vmcnt(0)" ::: "memory");
            const unsigned og = xb_add(&bar[XB_TOP], 1u);
            const unsigned tg = og / nx;
            if (og + 1u == (tg + 1u) * nx) xb_add(&bar[XB_TOPGEN], 1u);
            else XB_SPIN(xb_ld(&bar[XB_TOPGEN]) == tg, bar);
            __builtin_amdgcn_fence(__ATOMIC_ACQUIRE, "agent");
            xb_add(&bar[XB_XGEN(b.x)], 1u);
            asm volatile("s_waitcnt vmcnt(0)" ::: "memory");
        } else {
            XB_SPIN(xb_ld(&bar[XB_XGEN(b.x)]) == gen, bar);
            __builtin_amdgcn_fence(__ATOMIC_ACQUIRE, "agent");
            asm volatile("s_waitcnt vmcnt(0)" ::: "memory");
        }
    }
    __syncthreads();
}

struct Frame {
    LAS unsigned char* lds;
    volatile LAS unsigned* MISC;
    gu32* ctl;
    int vcu, G;
};
__device__ __forceinline__ float wave_sum(float v) {
#pragma unroll
    for (int o = 1; o < 64; o <<= 1) v += __shfl_xor(v, o);
    return v;
}
template <int CTRL> __device__ __forceinline__ float dppf(float x) { return __builtin_bit_cast(float, __builtin_amdgcn_update_dpp(0, __builtin_bit_cast(int, x), CTRL, 0xF, 0xF, true)); }
__device__ __forceinline__ float red8(float x) {
    x += dppf<0xB1>(x);
    x += dppf<0x4E>(x);
    x += dppf<0x141>(x);
    return x;
}

#define OPAQUE_TID() int tid = threadIdx.x; asm volatile("" : "+v"(tid)); const int lane = tid & 63, wave = __builtin_amdgcn_readfirstlane(tid >> 6); (void)lane; (void)wave
__device__ __forceinline__ int mix_src_col(int j0) {
    const int seg = j0 >> 8, r = j0 & 255;
    if (seg == 3) { const int h = r >> 6, part = (r >> 5) & 1; return (part ? 2952 : 2824) + 32 * h; }
    if (seg == 14) return r == 0 ? -2 : -1;
    const int base = seg == 0 ? 0 : seg == 1 ? 1024 : seg == 2 ? 2056 : seg == 4 ? 256 : seg == 5 ? 512 : seg == 6 ? 768 : seg == 7 ? 1280 : seg == 8 ? 1536 :
                     seg == 9 ? 1792 : seg == 10 ? 2312 : seg == 11 ? 2568 : seg == 12 ? 3080 : 3336;
    return base + r;
}
__device__ __forceinline__ void transpose_item(const float* W, int K, int Nsrc, const float* gain, bf16* WT, int k0, int n0, int srccol, int nvalid, LAS float* scr, int lane) {
    const int nl = lane & 31;
#pragma unroll 8
    for (int i = 0; i < 32; ++i) { const int kk = 2 * i + (lane >> 5);
        float v = 0.f;
        if (nl < nvalid) { v = W[(size_t)(k0 + kk) * Nsrc + srccol + nl]; if (gain) v *= gain[k0 + kk]; }
        scr[kk * 33 + nl] = v; }
    LDS_WAIT(); asm volatile("" ::: "memory");
    const int c = lane & 7;
#pragma unroll
    for (int j = 0; j < 4; ++j) { const int n = (lane >> 3) + 8 * j; const LAS float* s = scr + (8 * c) * 33 + n;
        v4u o; o.x = pk2(s[0 * 33], s[1 * 33]); o.y = pk2(s[2 * 33], s[3 * 33]); o.z = pk2(s[4 * 33], s[5 * 33]); o.w = pk2(s[6 * 33], s[7 * 33]);
        *(GAS v4u*)(WT + (size_t)(n0 + n) * K + k0 + 8 * c) = o; }
    LDS_WAIT(); asm volatile("" ::: "memory");
}

struct Args { const float* in[19]; float* out; unsigned char* ws; int ph_lo, ph_hi; };
enum { I_X = 0, I_F1N, I_F1WI, I_F1WO, I_MN, I_MWI, I_MWO, I_F2N, I_F2WI, I_F2WO, I_LB, I_HGN, I_CONV, I_ALOG, I_DTB, I_GDN, I_SBN, I_RETN, I_FN };

__device__ __forceinline__ void p0_prologue(Frame& F, const Args& a) {
    OPAQUE_TID();
    LAS float* scr = (LAS float*)(F.lds + RING_OFF + wave * 16384);
    const int gw = F.vcu * NWAVES + wave, NGW = F.G * NWAVES;
    constexpr int IT_FI = (DM / 64) * (NFI / 32), IT_FO = (DFF / 64) * (DM / 32), IT_MI = (DM / 64) * (NMIX / 32), IT_MO = (DM / 64) * (DM / 32);
    constexpr int IT_LAYER = 2 * IT_FI + 2 * IT_FO + IT_MI + IT_MO;
    for (int it = gw; it < DEPTH * IT_LAYER; it += NGW) {
        const int l = it / IT_LAYER; int r = it % IT_LAYER;
        bf16* wl = (bf16*)(a.ws + WS_W + (size_t)l * WL_BYTES);
        if (r < 2 * IT_FI) {
            const int half = r / IT_FI; r %= IT_FI;
            const int nb = r % (NFI / 32), kb = r / (NFI / 32), j0 = 32 * nb, pn = j0 >> 8, within = j0 & 255;
            const int src = within < 128 ? 128 * pn + within : DFF + 128 * pn + (within - 128);
            transpose_item((half ? a.in[I_F2WI] : a.in[I_F1WI]) + (size_t)l * DM * NFI, DM, NFI, (half ? a.in[I_F2N] : a.in[I_F1N]) + l * DM,
                           (bf16*)((char*)wl + (half ? WL_FI2 : WL_FI1)), 64 * kb, j0, src, 32, scr, lane);
            continue; }
        r -= 2 * IT_FI;
        if (r < 2 * IT_FO) {
            const int half = r / IT_FO; r %= IT_FO;
            const int nb = r % (DM / 32), kb = r / (DM / 32);
            transpose_item((half ? a.in[I_F2WO] : a.in[I_F1WO]) + (size_t)l * DFF * DM, DFF, DM, nullptr, (bf16*)((char*)wl + (half ? WL_FO2 : WL_FO1)), 64 * kb, 32 * nb, 32 * nb, 32, scr, lane);
            continue; }
        r -= 2 * IT_FO;
        if (r < IT_MI) {
            const int nb = r % (NMIX / 32), kb = r / (NMIX / 32), j0 = 32 * nb; int src = mix_src_col(j0), nv = 32;
            if (src == -1) { src = 0; nv = 0; } else if (src == -2) { src = 2048; nv = 8; }
            transpose_item(a.in[I_MWI] + (size_t)l * DM * NMIX_SRC, DM, NMIX_SRC, a.in[I_MN] + l * DM, (bf16*)((char*)wl + WL_MI), 64 * kb, j0, src, nv, scr, lane);
            continue; }
        r -= IT_MI;
        { const int nb = r % (DM / 32), kb = r / (DM / 32);
          transpose_item(a.in[I_MWO] + (size_t)l * DM * DM, DM, DM, nullptr, (bf16*)((char*)wl + WL_MO), 64 * kb, 32 * nb, 32 * nb, 32, scr, lane); }
    }
    {
        const float* x = a.in[I_X]; bf16* xb = (bf16*)(a.ws + WS_XB); float* ssq0 = (float*)(a.ws + WS_SSQ);
        for (int m = gw; m < M; m += NGW) {
            const GAS f32x4* xr = (const GAS f32x4*)(x + (size_t)m * DM) + lane;
            f32x4 v[4]; float s = 0.f;
#pragma unroll
            for (int j = 0; j < 4; ++j) { v[j] = xr[64 * j]; s += (v[j].x * v[j].x + v[j].y * v[j].y) + (v[j].z * v[j].z + v[j].w * v[j].w); }
            s = wave_sum(s);
            GAS unsigned long long* o8 = (GAS unsigned long long*)(xb + (size_t)m * DM) + lane;
#pragma unroll
            for (int j = 0; j < 4; ++j) o8[64 * j] = (unsigned long long)pk2(v[j].x, v[j].y) | ((unsigned long long)pk2(v[j].z, v[j].w) << 32);
            if (lane < 16) ssq0[(size_t)m * 16 + lane] = lane == 0 ? s : 0.f;
        }
    }
    {
        f32x2* rope = (f32x2*)(a.ws + WS_ROPE);
        for (int e = (F.vcu * NTHR + tid); e < SEQ * 16; e += F.G * NTHR) {
            const int t = e >> 4, i = e & 15;
            double invf = 1.0; for (int q = 0; q < i; ++q) invf *= 0.56234132519034907;
            const double ang = (double)t * invf;
            const double nq = __builtin_rint(ang * 0.63661977236758138);
            double r = __builtin_fma(-nq, 1.5707963267948966, ang); r = __builtin_fma(-nq, 6.123233995736766e-17, r);
            const double r2 = r * r;
            double sp = -1.0 / 6227020800.0; sp = sp * r2 + 1.0 / 39916800.0; sp = sp * r2 - 1.0 / 362880.0; sp = sp * r2 + 1.0 / 5040.0; sp = sp * r2 - 1.0 / 120.0; sp = sp * r2 + 1.0 / 6.0;
            const double sn = r - r * r2 * sp;
            double cp = 1.0 / 87178291200.0; cp = cp * r2 - 1.0 / 479001600.0; cp = cp * r2 + 1.0 / 3628800.0; cp = cp * r2 - 1.0 / 40320.0; cp = cp * r2 + 1.0 / 720.0; cp = cp * r2 - 1.0 / 24.0; cp = cp * r2 + 0.5;
            const double cs = 1.0 - r2 * cp;
            const int qd = ((int)nq) & 3;
            const double s_out = qd == 0 ? sn : qd == 1 ? cs : qd == 2 ? -sn : -cs;
            const double c_out = qd == 0 ? cs : qd == 1 ? -sn : qd == 2 ? -cs : sn;
            rope[e] = (f32x2){(float)c_out, (float)s_out};
        }
    }
}

struct MixCtx { bf16* proj; int l; const Args* a; };

__device__ __forceinline__ void ld8bf(const bf16* p, float (&o)[8]) {
    const v4u u = *(const GAS v4u*)p;
    o[0] = bflo(u.x); o[1] = bfhi(u.x); o[2] = bflo(u.y); o[3] = bfhi(u.y); o[4] = bflo(u.z); o[5] = bfhi(u.z); o[6] = bflo(u.w); o[7] = bfhi(u.w);
}
__device__ __forceinline__ void st8f(LAS float* p, const float (&v)[8]) { *(LAS f32x4*)p = (f32x4){v[0], v[1], v[2], v[3]}; *(LAS f32x4*)(p + 4) = (f32x4){v[4], v[5], v[6], v[7]}; }
__device__ __forceinline__ void ld8f(const LAS float* p, float (&v)[8]) { const f32x4 a = *(const LAS f32x4*)p, b = *(const LAS f32x4*)(p + 4); v[0] = a.x; v[1] = a.y; v[2] = a.z; v[3] = a.w; v[4] = b.x; v[5] = b.y; v[6] = b.z; v[7] = b.w; }

template <int GATE>
__device__ __forceinline__ void scan_epilogue(const LAS float* obuf, bf16* proj, size_t row, int ycol, int gcol, const float* ng, int t, int c) {
    float o[8]; ld8f(obuf + t * 64 + 8 * c, o);
    float ss = 0.f;
#pragma unroll
    for (int e = 0; e < 8; ++e) ss += o[e] * o[e];
    ss = red8(ss);
    const float rstd = __builtin_amdgcn_rsqf(ss * (1.f / 64.f) + EPS);
    float g[8]; ld8bf(proj + row * NMIX + gcol + 8 * c, g);
    float y[8];
#pragma unroll
    for (int e = 0; e < 8; ++e) y[e] = o[e] * rstd * ng[8 * c + e] * (GATE == 0 ? fsigmoid(g[e]) : fsilu(g[e]));
    v4u w; w.x = pk2(y[0], y[1]); w.y = pk2(y[2], y[3]); w.z = pk2(y[4], y[5]); w.w = pk2(y[6], y[7]);
    *(GAS v4u*)(proj + row * NMIX + ycol + 8 * c) = w;
}

__device__ __forceinline__ void scan_hgrn2(Frame& F, const MixCtx& X, int b, int h) {
    OPAQUE_TID();
    LAS float* qs = (LAS float*)(F.lds + RING_OFF); LAS float* fs = qs + 4096; LAS float* is = fs + 4096; LAS float* obuf = is + 4096;
    const int t = tid >> 3, c = tid & 7, vl = lane >> 3, kg = lane & 7, v = 8 * wave + vl;
    float lb[8];
    { const float* lg = X.a->in[I_LB];
#pragma unroll
      for (int e = 0; e < 8; ++e) { const int ch = h * 64 + 8 * c + e; const float x0 = lg[ch], x1 = lg[256 + ch], x2 = lg[512 + ch], x3 = lg[768 + ch];
          const float mx = fmaxf(fmaxf(x0, x1), fmaxf(x2, x3)); const float e0 = fexp(x0 - mx), e1 = fexp(x1 - mx), e2 = fexp(x2 - mx), e3 = fexp(x3 - mx);
          const float inv = 1.f / (e0 + e1 + e2 + e3); const float c1 = e1 * inv, c2 = c1 + e2 * inv, c3 = c2 + e3 * inv;
          lb[e] = X.l == 0 ? 0.f : X.l == 1 ? c1 : X.l == 2 ? c2 : c3; } }
    const float* ng = X.a->in[I_HGN] + X.l * 256 + h * 64;
    float S[8];
#pragma unroll
    for (int e = 0; e < 8; ++e) S[e] = 0.f;
    for (int n = 0; n < NCHUNK; ++n) {
        const size_t row = (size_t)b * SEQ + n * CHUNK + t;
        { float q[8], f[8], iv[8];
          ld8bf(X.proj + row * NMIX + C_AQ + h * 64 + 8 * c, q); ld8bf(X.proj + row * NMIX + C_AF + h * 64 + 8 * c, f); ld8bf(X.proj + row * NMIX + C_AI + h * 64 + 8 * c, iv);
#pragma unroll
          for (int e = 0; e < 8; ++e) { q[e] = fsilu(q[e]); f[e] = lb[e] + (1.f - lb[e]) * fsigmoid(f[e]); iv[e] = fsilu(iv[e]); }
          st8f(qs + t * 64 + 8 * c, q); st8f(fs + t * 64 + 8 * c, f); st8f(is + t * 64 + 8 * c, iv); }
        __syncthreads();
#pragma unroll 4
        for (int s = 0; s < CHUNK; ++s) {
            float f8[8], q8[8]; ld8f(fs + s * 64 + 8 * kg, f8); ld8f(qs + s * 64 + 8 * kg, q8);
            const float iv = is[s * 64 + v];
            float po = 0.f;
#pragma unroll
            for (int e = 0; e < 8; ++e) { S[e] = f8[e] * S[e] + (1.f - f8[e]) * iv; po += q8[e] * S[e]; }
            po = red8(po);
            if (kg == 0) obuf[s * 64 + v] = po;
        }
        __syncthreads();
        scan_epilogue<0>(obuf, X.proj, row, Y_A + h * 64, C_AG + h * 64, ng, t, c);
    }
    __syncthreads();
}

__device__ __forceinline__ void scan_retention(Frame& F, const MixCtx& X, int b, int h) {
    OPAQUE_TID();
    LAS float* qs = (LAS float*)(F.lds + RING_OFF); LAS float* ks = qs + 2048; LAS float* vs = ks + 2048; LAS float* obuf = vs + 4096;
    const int t = tid >> 3, c = tid & 7, vl = lane >> 3, kg = lane & 7, v = 8 * wave + vl;
    const float gamma = 1.f - __builtin_amdgcn_exp2f(-5.f - (float)h);
    const float* ng = X.a->in[I_RETN] + X.l * 256 + h * 64;
    const f32x2* rope = (const f32x2*)(X.a->ws + WS_ROPE);
    float S[4] = {0.f, 0.f, 0.f, 0.f};
    for (int n = 0; n < NCHUNK; ++n) {
        const int tpos = n * CHUNK + t; const size_t row = (size_t)b * SEQ + tpos;
        {
          float x[8], p[8]; ld8bf(X.proj + row * NMIX + C_DQK + h * 64 + 8 * c, x);
#pragma unroll
          for (int e = 0; e < 8; ++e) p[e] = __shfl_xor(x[e], 2);
          const int i0 = 8 * (c & 1); const bool hi = (c & 2) != 0; const float sc = c >= 4 ? 0.17677669529663687f : 1.f;
          float o[8];
#pragma unroll
          for (int e = 0; e < 8; ++e) { const f32x2 cs = rope[tpos * 16 + i0 + e];
              o[e] = (hi ? (p[e] * cs.y + x[e] * cs.x) : (x[e] * cs.x - p[e] * cs.y)) * sc; }
          LAS float* dst = (c < 4 ? qs : ks) + t * 32 + 8 * (c & 3); st8f(dst, o);
          float vv[8]; ld8bf(X.proj + row * NMIX + C_DV + h * 64 + 8 * c, vv); st8f(vs + t * 64 + 8 * c, vv); }
        __syncthreads();
#pragma unroll 4
        for (int s = 0; s < CHUNK; ++s) {
            const f32x4 k4 = *(const LAS f32x4*)(ks + s * 32 + 4 * kg), q4 = *(const LAS f32x4*)(qs + s * 32 + 4 * kg);
            const float vv = vs[s * 64 + v];
            S[0] = gamma * S[0] + k4.x * vv; S[1] = gamma * S[1] + k4.y * vv; S[2] = gamma * S[2] + k4.z * vv; S[3] = gamma * S[3] + k4.w * vv;
            float po = (q4.x * S[0] + q4.y * S[1]) + (q4.z * S[2] + q4.w * S[3]);
            po = red8(po);
            if (kg == 0) obuf[s * 64 + v] = po;
        }
        __syncthreads();
        scan_epilogue<1>(obuf, X.proj, row, Y_D + h * 64, C_DG + h * 64, ng, t, c);
    }
    __syncthreads();
}

__device__ __forceinline__ void scan_gdn(Frame& F, const MixCtx& X, int b, int h) {
    OPAQUE_TID();
    LAS float* qs = (LAS float*)(F.lds + RING_OFF); LAS float* ks = qs + 4096; LAS float* vs = ks + 4096; LAS float* obuf = vs + 4096;
    LAS float* ab = obuf + 4096;
    LAS float* cw = ab + 128;
    LAS bf16* raw = (LAS bf16*)(cw + 768);
    const int t = tid >> 3, c = tid & 7, vl = lane >> 3, kg = lane & 7, v = 8 * wave + vl;
    const float* ng = X.a->in[I_GDN] + X.l * 256 + h * 64;
    const float a_exp = fexp(X.a->in[I_ALOG][X.l * 4 + h]), dtb = X.a->in[I_DTB][X.l * 4 + h];
    { const float* w = X.a->in[I_CONV] + (size_t)X.l * 4 * 768;
      for (int i = tid; i < 768; i += NTHR) { const int g = i >> 8, j = (i >> 6) & 3, ch = i & 63; cw[i] = w[j * 768 + g * 256 + h * 64 + ch]; }
      for (int i = tid; i < 3 * 3 * 64; i += NTHR) { const int g = i / 192, r = (i % 192) >> 6, ch = i & 63; raw[(g * 67 + r) * 64 + ch] = 0; } }
    float S[8];
#pragma unroll
    for (int e = 0; e < 8; ++e) S[e] = 0.f;
    __syncthreads();
    for (int n = 0; n < NCHUNK; ++n) {
        const size_t row = (size_t)b * SEQ + n * CHUNK + t;
        { const v4u uq = *(const GAS v4u*)(X.proj + row * NMIX + C_BQ + h * 64 + 8 * c), uk = *(const GAS v4u*)(X.proj + row * NMIX + C_BK + h * 64 + 8 * c),
                    uv = *(const GAS v4u*)(X.proj + row * NMIX + C_BV + h * 64 + 8 * c);
          *(LAS v4u*)(raw + (0 * 67 + 3 + t) * 64 + 8 * c) = uq; *(LAS v4u*)(raw + (1 * 67 + 3 + t) * 64 + 8 * c) = uk; *(LAS v4u*)(raw + (2 * 67 + 3 + t) * 64 + 8 * c) = uv; }
        if (tid < 64) { const float av = bflo((unsigned)X.proj[((size_t)b * SEQ + n * CHUNK + tid) * NMIX + C_BA + h]), bv = bflo((unsigned)X.proj[((size_t)b * SEQ + n * CHUNK + tid) * NMIX + C_BB + h]);
            const float z = av + dtb; const float sp = fmaxf(z, 0.f) + __builtin_amdgcn_logf(1.f + fexp(-fabsf(z))) * 0.6931471805599453f;
            ab[tid] = fexp(-a_exp * sp); ab[64 + tid] = fsigmoid(bv); }
        __syncthreads();
        {
          float y[3][8];
#pragma unroll
          for (int g = 0; g < 3; ++g) {
#pragma unroll
              for (int e = 0; e < 8; ++e) y[g][e] = 0.f;
#pragma unroll
              for (int j = 0; j < 4; ++j) { const v4u u = *(const LAS v4u*)(raw + (g * 67 + t + j) * 64 + 8 * c); float w8[8]; ld8f(cw + (g * 4 + j) * 64 + 8 * c, w8);
                  y[g][0] += bflo(u.x) * w8[0]; y[g][1] += bfhi(u.x) * w8[1]; y[g][2] += bflo(u.y) * w8[2]; y[g][3] += bfhi(u.y) * w8[3];
                  y[g][4] += bflo(u.z) * w8[4]; y[g][5] += bfhi(u.z) * w8[5]; y[g][6] += bflo(u.w) * w8[6]; y[g][7] += bfhi(u.w) * w8[7]; }
#pragma unroll
              for (int e = 0; e < 8; ++e) y[g][e] = fsilu(y[g][e]); }
          float sq = 0.f, sk = 0.f;
#pragma unroll
          for (int e = 0; e < 8; ++e) { sq += y[0][e] * y[0][e]; sk += y[1][e] * y[1][e]; }
          sq = red8(sq); sk = red8(sk);
          const float rq = __builtin_amdgcn_rsqf(sq + EPS) * 0.125f, rk = __builtin_amdgcn_rsqf(sk + EPS);
#pragma unroll
          for (int e = 0; e < 8; ++e) { y[0][e] *= rq; y[1][e] *= rk; }
          st8f(qs + t * 64 + 8 * c, y[0]); st8f(ks + t * 64 + 8 * c, y[1]); st8f(vs + t * 64 + 8 * c, y[2]); }
        __syncthreads();
        if (tid < 3 * 3 * 8) { const int g = tid / 24, r = (tid % 24) >> 3, cc = tid & 7;
            *(LAS v4u*)(raw + (g * 67 + r) * 64 + 8 * cc) = *(const LAS v4u*)(raw + (g * 67 + 64 + r) * 64 + 8 * cc); }
#pragma unroll 2
        for (int s = 0; s < CHUNK; ++s) {
            float k8[8], q8[8]; ld8f(ks + s * 64 + 8 * kg, k8); ld8f(qs + s * 64 + 8 * kg, q8);
            const float vv = vs[s * 64 + v], al = ab[s], be = ab[64 + s];
            float pk = 0.f;
#pragma unroll
            for (int e = 0; e < 8; ++e) pk += k8[e] * S[e];
            pk = red8(pk);
            const float d = be * (vv - al * pk);
            float po = 0.f;
#pragma unroll
            for (int e = 0; e < 8; ++e) { S[e] = al * S[e] + k8[e] * d; po += q8[e] * S[e]; }
            po = red8(po);
            if (kg == 0) obuf[s * 64 + v] = po;
        }
        __syncthreads();
        scan_epilogue<1>(obuf, X.proj, row, Y_B + h * 64, C_BG + h * 64, ng, t, c);
    }
    __syncthreads();
}

__device__ __forceinline__ float dot2bf(unsigned a, unsigned b, float acc) {
    typedef __bf16 bf2 __attribute__((ext_vector_type(2)));
    return __builtin_amdgcn_fdot2_f32_bf16(__builtin_bit_cast(bf2, a), __builtin_bit_cast(bf2, b), acc, false);
}
__device__ __forceinline__ void sb_block(Frame& F, const MixCtx& X, int b, int h, int qb) {
    OPAQUE_TID();
    const int qi = lane & 31, half = lane >> 5, t = qb * 32 + qi;
    const size_t rowq = (size_t)b * SEQ + t;
    unsigned q[16];
    { const GAS v4u* p = (const GAS v4u*)(X.proj + rowq * NMIX + C_CQ + h * 64 + 32 * half);
#pragma unroll
      for (int j = 0; j < 4; ++j) { const v4u u = p[j]; q[4 * j] = u.x; q[4 * j + 1] = u.y; q[4 * j + 2] = u.z; q[4 * j + 3] = u.w; } }
    float o[32];
#pragma unroll
    for (int i = 0; i < 32; ++i) o[i] = 0.f;
    float P = 1.f;
    const bf16* kbase = X.proj + (size_t)b * SEQ * NMIX + C_CK + h * 64 + 32 * half;
    const bf16* vbase = X.proj + (size_t)b * SEQ * NMIX + C_CV + h * 64 + 32 * half;
    for (int s = qb * 32 + 31; s >= 0; --s) {
        const GAS v4u* kp = (const GAS v4u*)(kbase + (size_t)s * NMIX); const GAS v4u* vp = (const GAS v4u*)(vbase + (size_t)s * NMIX);
        v4u ku[4], vu[4];
#pragma unroll
        for (int j = 0; j < 4; ++j) { ku[j] = kp[j]; vu[j] = vp[j]; }
        float d = 0.f;
#pragma unroll
        for (int j = 0; j < 4; ++j) { d = dot2bf(q[4 * j], ku[j].x, d); d = dot2bf(q[4 * j + 1], ku[j].y, d); d = dot2bf(q[4 * j + 2], ku[j].z, d); d = dot2bf(q[4 * j + 3], ku[j].w, d); }
        d += __shfl_xor(d, 32);
        const float z2 = fminf(d * (0.125f * 1.4426950408889634f), 80.f);
        const float e = __builtin_amdgcn_exp2f(z2), r = __builtin_amdgcn_rcpf(1.f + e);
        const bool valid = s < t;
        const float w = valid ? e * r * P : 0.f;
        P = valid ? P * r : P;
#pragma unroll
        for (int j = 0; j < 4; ++j) {
            o[8 * j + 0] += w * bflo(vu[j].x); o[8 * j + 1] += w * bfhi(vu[j].x); o[8 * j + 2] += w * bflo(vu[j].y); o[8 * j + 3] += w * bfhi(vu[j].y);
            o[8 * j + 4] += w * bflo(vu[j].z); o[8 * j + 5] += w * bfhi(vu[j].z); o[8 * j + 6] += w * bflo(vu[j].w); o[8 * j + 7] += w * bfhi(vu[j].w); }
    }
    float ss = 0.f;
#pragma unroll
    for (int i = 0; i < 32; ++i) ss += o[i] * o[i];
    ss += __shfl_xor(ss, 32);
    const float rstd = __builtin_amdgcn_rsqf(ss * (1.f / 64.f) + EPS);
    const float* ng = X.a->in[I_SBN] + X.l * 256 + h * 64 + 32 * half;
    GAS v4u* yp = (GAS v4u*)(X.proj + rowq * NMIX + Y_C + h * 64 + 32 * half);
#pragma unroll
    for (int j = 0; j < 4; ++j) { v4u w;
        w.x = pk2(o[8 * j + 0] * rstd * ng[8 * j + 0], o[8 * j + 1] * rstd * ng[8 * j + 1]); w.y = pk2(o[8 * j + 2] * rstd * ng[8 * j + 2], o[8 * j + 3] * rstd * ng[8 * j + 3]);
        w.z = pk2(o[8 * j + 4] * rstd * ng[8 * j + 4], o[8 * j + 5] * rstd * ng[8 * j + 5]); w.w = pk2(o[8 * j + 6] * rstd * ng[8 * j + 6], o[8 * j + 7] * rstd * ng[8 * j + 7]);
        yp[j] = w; }
}

constexpr int MIX_UNITS = 448;
__device__ __forceinline__ void mixers_phase(Frame& F, const MixCtx& X) {
    OPAQUE_TID();
    gu32* head = F.ctl + CW_QUEUE + 64 * X.l;
    for (;;) {
        __syncthreads();
        if (tid == 0) F.MISC[16] = __hip_atomic_fetch_add(head, 1u, RLX_AGENT);
        __syncthreads();
        const int u = (int)F.MISC[16];
        if (u >= MIX_UNITS) break;
        if (u < 64) scan_gdn(F, X, u >> 2, u & 3);
        else if (u < 128) scan_hgrn2(F, X, (u - 64) >> 2, (u - 64) & 3);
        else if (u < 192) scan_retention(F, X, (u - 128) >> 2, (u - 128) & 3);
        else { const int a = u - 192, bh = a >> 2, pi = (a & 3) * 8 + wave;
            sb_block(F, X, bh >> 2, bh & 3, 63 - pi); sb_block(F, X, bh >> 2, bh & 3, pi); }
    }
}

__device__ __forceinline__ void final_norm(Frame& F, float* x, const float* g) {
    OPAQUE_TID();
    const int gw = F.vcu * NWAVES + wave, NGW = F.G * NWAVES;
    f32x4 gv[4];
#pragma unroll
    for (int j = 0; j < 4; ++j) gv[j] = ((const f32x4*)g)[lane + 64 * j];
    for (int m = gw; m < M; m += NGW) {
        GAS f32x4* xr = (GAS f32x4*)(x + (size_t)m * DM) + lane;
        f32x4 v[4]; float s = 0.f;
#pragma unroll
        for (int j = 0; j < 4; ++j) { v[j] = xr[64 * j]; s += (v[j].x * v[j].x + v[j].y * v[j].y) + (v[j].z * v[j].z + v[j].w * v[j].w); }
        s = wave_sum(s);
        const float rstd = 1.f / sqrtf(s * (1.f / DM) + EPS);
#pragma unroll
        for (int j = 0; j < 4; ++j) xr[64 * j] = v[j] * rstd * gv[j];
    }
}

constexpr int PH_PRO = 0, PH_PER_J = 6, PH_FINAL = 1 + 8 * PH_PER_J, NPH = PH_FINAL + 1;
__global__ void __launch_bounds__(NTHR, 2) fwd_kernel(Args args) {
    extern __shared__ __attribute__((aligned(16))) unsigned char lds[];
    Frame F;
    F.lds = (LAS unsigned char*)lds;
    F.MISC = (volatile LAS unsigned*)(F.lds + MISC_OFF);
    F.G = gridDim.x; { const int bx = blockIdx.x; F.vcu = (F.G % 8 == 0) ? (bx % 8) * (F.G / 8) + bx / 8 : bx; }
    unsigned char* ws = args.ws;
    F.ctl = (gu32*)(ws + WS_CTL);
    for (int u = threadIdx.x; u < (LDS_BYTES - LDSCTL_OFF) / 4; u += NTHR) ((LAS unsigned*)(F.lds + LDSCTL_OFF))[u] = 0u;
    __syncthreads();
    const int lo = args.ph_lo, hi = args.ph_hi;
    const bool multi = (hi - lo) > 1;
    XcdBarrier bar; bar.bar = (unsigned*)(F.ctl + CW_BAR); bar.x = 0; bar.st = nullptr;
    if (multi) bar = xcd_barrier_post((unsigned*)(F.ctl + CW_BAR), F.MISC + 8);
#define IN(k) (lo <= (k) && (k) < hi)
#define GRID_BAR() do { if (multi) xcd_barrier(bar); } while (0)

    bf16* xb = (bf16*)(ws + WS_XB);
    bf16* big = (bf16*)(ws + WS_BIG);
    float* ssq = (float*)(ws + WS_SSQ);

    if (IN(PH_PRO)) { p0_prologue(F, args); GRID_BAR(); }

    for (int j = 0; j < 8; ++j) {
        const int l = j >> 1, odd = j & 1, pb = 1 + j * PH_PER_J;
        const unsigned char* wl = ws + WS_W + (size_t)l * WL_BYTES;
        if (IN(pb + 0)) {
            pg8::Gemm g{xb, (const bf16*)(wl + (odd ? WL_FI2 : WL_FI1)), M, NFI, DM, DM}; pg8::StaticOrder S; S.init(M, NFI, F.G, (int)blockIdx.x);
            pg8::EpiSwiglu E{big, DFF, ssq, 1.f / DM};
            pg8::gemm_phase<pg8::EpiSwiglu, pg8::StaticOrder, true, true>(F.lds + RING_OFF, g, S, E);
            GRID_BAR();
        }
        if (IN(pb + 1)) {
            pg8::Gemm g{big, (const bf16*)(wl + (odd ? WL_FO2 : WL_FO1)), M, DM, DFF, DFF}; pg8::StaticOrder S; S.init(M, DM, F.G, (int)blockIdx.x);
            pg8::EpiResid E{j == 0 ? args.in[I_X] : args.out, args.out, xb, ssq, DM, 0.5f};
            pg8::gemm_phase<pg8::EpiResid, pg8::StaticOrder, true, true>(F.lds + RING_OFF, g, S, E);
            GRID_BAR();
        }
        if (!odd) {
            if (IN(pb + 2)) {
                pg8::Gemm g{xb, (const bf16*)(wl + WL_MI), M, NMIX, DM, DM}; pg8::StaticOrder S; S.init(M, NMIX, F.G, (int)blockIdx.x);
                pg8::EpiProj E{big, NMIX, ssq, 1.f / DM};
                pg8::gemm_phase<pg8::EpiProj, pg8::StaticOrder, true, true>(F.lds + RING_OFF, g, S, E);
                GRID_BAR();
            }
            if (IN(pb + 3)) {
                MixCtx X{big, l, &args};
                mixers_phase(F, X);
                GRID_BAR();
            }
            if (IN(pb + 4)) {
                pg8::Gemm g{big, (const bf16*)(wl + WL_MO), M, DM, DM, NMIX}; pg8::StaticOrder S; S.init(M, DM, F.G, (int)blockIdx.x);
                pg8::EpiResid E{args.out, args.out, xb, ssq, DM, 1.f};
                pg8::gemm_phase<pg8::EpiResid, pg8::StaticOrder, true, true>(F.lds + RING_OFF, g, S, E);
                GRID_BAR();
            }
        }
    }
    if (IN(PH_FINAL)) final_norm(F, args.out, args.in[I_FN]);
#undef IN
#undef GRID_BAR
}

#ifndef MK_PER_PHASE
#define MK_PER_PHASE 0
#endif
extern "C" void kernel_launch(void* const* d_in, const int* in_sizes, int n_in, void* d_out, int out_size, void* d_ws, size_t ws_size, hipStream_t stream) {
    static int grid = 0;
    if (grid == 0) {
        if (n_in != 19 || in_sizes[0] != M * DM || out_size != M * DM || ws_size < WS_END) {
            fprintf(stderr, "kernel_launch: built for 19 inputs, x/out of %d floats, >= %zu bytes of workspace; got n_in %d, in0 %d, out %d, ws %zu; nothing launched\n", M * DM, (size_t)WS_END, n_in, n_in > 0 ? in_sizes[0] : -1, out_size, ws_size);
            grid = -1; return; }
        int dev = 0, cus = 0, per_cu = 0;
        if (hipGetDevice(&dev) != hipSuccess || hipDeviceGetAttribute(&cus, hipDeviceAttributeMultiprocessorCount, dev) != hipSuccess) { fprintf(stderr, "kernel_launch: device query failed\n"); grid = -1; return; }
        if (hipFuncSetAttribute((const void*)fwd_kernel, hipFuncAttributeMaxDynamicSharedMemorySize, LDS_BYTES) != hipSuccess) { fprintf(stderr, "kernel_launch: hipFuncSetAttribute failed\n"); grid = -1; return; }
        if (hipOccupancyMaxActiveBlocksPerMultiprocessor(&per_cu, (const void*)fwd_kernel, NTHR, LDS_BYTES) != hipSuccess || per_cu < 1)
            fprintf(stderr, "kernel_launch: note: occupancy query reports %d workgroups per CU\n", per_cu);
        (void)hipGetLastError();
        grid = cus;
    }
    if (grid < 0) return;
    if (hipMemsetAsync((char*)d_ws + WS_CTL, 0, CTL_ZERO_BYTES, stream) != hipSuccess) { fprintf(stderr, "kernel_launch: hipMemsetAsync failed\n"); return; }
    Args a{};
    for (int i = 0; i < 19; ++i) a.in[i] = (const float*)d_in[i];
    a.out = (float*)d_out; a.ws = (unsigned char*)d_ws;
#if MK_PER_PHASE
    for (int p = 0; p < NPH; ++p) {
        if (p >= 1 && p < PH_FINAL) { const int j = (p - 1) / PH_PER_J, k = (p - 1) % PH_PER_J; if (k == 5 || ((j & 1) && k >= 2)) continue; }
        a.ph_lo = p; a.ph_hi = p + 1;
        hipLaunchKernelGGL(fwd_kernel, dim3(grid), dim3(NTHR), LDS_BYTES, stream, a);
    }
#else
    a.ph_lo = 0; a.ph_hi = NPH;
    hipLaunchKernelGGL(fwd_kernel, dim3(grid), dim3(NTHR), LDS_BYTES, stream, a);
#endif
    const hipError_t le = hipPeekAtLastError();
    if (le != hipSuccess) fprintf(stderr, "kernel_launch: launch failed: %s\n", hipGetErrorName(le));
}
```

```cpp
#include <hip/hip_runtime.h>
#include <cstdio>
#include <cstdint>

namespace pg8 {
#define PG8_LAS __attribute__((address_space(3)))
typedef unsigned short bf16_t;
typedef short bf16x8 __attribute__((ext_vector_type(8)));
typedef float f32x4 __attribute__((ext_vector_type(4)));
typedef unsigned u32x4 __attribute__((ext_vector_type(4)));
constexpr int BM = 256, BK = 64, HALF = 128, HTB = HALF * BK * 2  , STAGE_BYTES = 8 * HTB, NXCD = 8, WGM = 8;

__host__ __device__ __forceinline__ int lds_byte(int r, int c) { const int st = (r >> 4) * 2 + (c >> 5), rr = r & 15, cc = c & 31, ob = rr * 64 + cc * 2; return st * 1024 + (ob ^ (((ob >> 9) & 1) << 5)); }
__host__ __device__ __forceinline__ void stage_rc(int b, int& R, int& C) { const int st = b / 1024, sb = b % 1024, swz = sb ^ (((sb >> 9) & 1) << 5); R = (st >> 1) * 16 + swz / 64; C = (st & 1) * 32 + (swz % 64) / 2; }
__host__ __device__ __forceinline__ int perm32(int rho) { const int n = rho >> 4, i = rho & 15; return 8 * (i >> 2) + 4 * n + (i & 3); }

struct Unit { int pm, pn; };
struct Gemm { const bf16_t* A; const bf16_t* Bt; int M, N, K, lda; };

struct StaticOrder {
    int nM, nN, nwg, G, c;
    __host__ __device__ void init(int M, int N, int G_, int c_) { nM = M / BM; nN = N / BM; nwg = nM * nN; G = G_; c = c_; }
    __host__ __device__ bool next(int i, Unit& u) const {
        const long L = (long)i * G + c; if (L >= nwg) return false;
        int wgid = (int)L; { const int q = nwg / NXCD, r = nwg % NXCD, xcd = wgid % NXCD, off = wgid / NXCD; wgid = (xcd < r ? xcd * (q + 1) : r * (q + 1) + (xcd - r) * q) + off; }
        const int nig = WGM * nN, gid = wgid / nig, fm = gid * WGM, gsz = (nM - fm) < WGM ? (nM - fm) : WGM;
        u.pm = fm + ((wgid % nig) % gsz); u.pn = (wgid % nig) / gsz; return true;
    }
    __device__ __forceinline__ void a_ready(const Unit&) const {}
    __device__ __forceinline__ void done(const Unit&) const {}
};

__device__ __forceinline__ unsigned cvt_pk_bf16(float lo, float hi) { unsigned r; asm volatile("v_cvt_pk_bf16_f32 %0, %1, %2" : "=v"(r) : "v"(lo), "v"(hi)); return r; }

constexpr float RMS_EPS = 1e-6f;

__device__ __forceinline__ float row_ssq(const float* ssq, int row, int fq) {
    const f32x4 p = *(const f32x4*)(ssq + (size_t)row * 16 + 4 * fq);
    float s = (p.x + p.y) + (p.z + p.w);
    s += __shfl_xor(s, 16); s += __shfl_xor(s, 32);
    return s;
}
__device__ __forceinline__ void row_rstd8(const float* ssq, float inv_k, PG8_LAS float* rs, int& last_pm, const Unit& u, int wr, int wc, int fr, int fq, float (&rstd)[8]) {
    PG8_LAS float* mine = rs + (wr * 4 + wc) * 128;
    if (u.pm != last_pm) {
        const int row0 = u.pm * BM + wr * 64 + fr;
        f32x4 p[8];
#pragma unroll
        for (int j = 0; j < 8; ++j) p[j] = *(const f32x4*)(ssq + (size_t)(row0 + (j >> 2) * HALF + (j & 3) * 16) * 16 + 4 * fq);
#pragma unroll
        for (int j = 0; j < 8; ++j) { float s = (p[j].x + p[j].y) + (p[j].z + p[j].w); s += __shfl_xor(s, 16); s += __shfl_xor(s, 32);
            const float r = __builtin_amdgcn_rsqf(s * inv_k + RMS_EPS); rstd[j] = r; if (fq == 0) mine[(j >> 2) * 64 + (j & 3) * 16 + fr] = r; }
        last_pm = u.pm;
    } else {
#pragma unroll
        for (int j = 0; j < 8; ++j) rstd[j] = mine[(j >> 2) * 64 + (j & 3) * 16 + fr];
    }
}
struct EpiSwiglu {
    static constexpr bool PERM = true, AFTER_DRAIN = false;
    bf16_t* O; int ldc; const float* ssq; float inv_k; PG8_LAS float* rs; mutable int last_pm;
    __device__ __forceinline__ void operator()(const f32x4 (&acc)[2][2][4][2], const Unit& u, int wr, int wc, int fr, int fq) const {
        typedef float f2 __attribute__((ext_vector_type(2)));
        const int row0 = u.pm * BM + wr * 64 + fr, ch0 = u.pn * HALF + wc * 32 + 8 * fq;
        float rstd[8]; row_rstd8(ssq, inv_k, rs, last_pm, u, wr, wc, fr, fq, rstd);
#pragma unroll
        for (int ai = 0; ai < 2; ++ai)
#pragma unroll
            for (int m = 0; m < 4; ++m) {
                const int row = row0 + ai * HALF + m * 16;
                const float rg = rstd[ai * 4 + m] * 1.4426950408889634f, ru = rstd[ai * 4 + m] * 0.6931471805599453f;
                const f2 rg2 = {rg, rg}, ru2 = {ru, ru};
                unsigned w[4];
#pragma unroll
                for (int n = 0; n < 2; ++n)
#pragma unroll
                    for (int p = 0; p < 2; ++p) {
                        const f2 gl = (f2){acc[ai][0][m][n][2 * p], acc[ai][0][m][n][2 * p + 1]} * rg2, up = (f2){acc[ai][1][m][n][2 * p], acc[ai][1][m][n][2 * p + 1]} * ru2;
                        f2 d = {__builtin_amdgcn_exp2f(-gl.x), __builtin_amdgcn_exp2f(-gl.y)}; d = d + (f2){1.f, 1.f};
                        const f2 sg = {__builtin_amdgcn_rcpf(d.x), __builtin_amdgcn_rcpf(d.y)};
                        const f2 o = (gl * sg) * up;
                        w[n * 2 + p] = cvt_pk_bf16(o.x, o.y);
                    }
                *(u32x4*)(O + (size_t)row * ldc + ch0) = (u32x4){w[0], w[1], w[2], w[3]};
            }
    }
};
struct EpiProj {
    static constexpr bool PERM = true, AFTER_DRAIN = false;
    bf16_t* O; int ldc; const float* ssq; float inv_k; PG8_LAS float* rs; mutable int last_pm;
    __device__ __forceinline__ void operator()(const f32x4 (&acc)[2][2][4][2], const Unit& u, int wr, int wc, int fr, int fq) const {
        const int row0 = u.pm * BM + wr * 64 + fr, col0 = u.pn * BM + wc * 32 + 8 * fq;
        float rstd8[8]; row_rstd8(ssq, inv_k, rs, last_pm, u, wr, wc, fr, fq, rstd8);
#pragma unroll
        for (int ai = 0; ai < 2; ++ai)
#pragma unroll
            for (int m = 0; m < 4; ++m) {
                const int row = row0 + ai * HALF + m * 16;
                const float rstd = rstd8[ai * 4 + m];
#pragma unroll
                for (int bj = 0; bj < 2; ++bj) {
                    const f32x4 v0 = acc[ai][bj][m][0] * rstd, v1 = acc[ai][bj][m][1] * rstd;
                    u32x4 w; w.x = cvt_pk_bf16(v0[0], v0[1]); w.y = cvt_pk_bf16(v0[2], v0[3]); w.z = cvt_pk_bf16(v1[0], v1[1]); w.w = cvt_pk_bf16(v1[2], v1[3]);
                    *(u32x4*)(O + (size_t)row * ldc + col0 + bj * HALF) = w;
                }
            }
    }
};
struct EpiResid {
    static constexpr bool PERM = true, AFTER_DRAIN = false;
    const float* xin32; float* xout32; bf16_t* xb; float* ssq_out; int ldx; float scale;
    const bf16_t* wab; float* abp;
    __device__ __forceinline__ void operator()(const f32x4 (&acc)[2][2][4][2], const Unit& u, int wr, int wc, int fr, int fq) const {
        const int row0 = u.pm * BM + wr * 64 + fr, col0 = u.pn * BM + wc * 32 + 8 * fq;
        bf16x8 wfr[2] = {};
        if (wab) { wfr[0] = *(const bf16x8*)(wab + (size_t)fr * ldx + col0); wfr[1] = *(const bf16x8*)(wab + (size_t)fr * ldx + col0 + HALF); }
        auto finish = [&](const int ai, const int m, const f32x4 (&x)[2][2]) {
            const int row = row0 + ai * HALF + m * 16;
            float ss = 0.f; f32x4 ab = {0.f, 0.f, 0.f, 0.f};
#pragma unroll
            for (int bj = 0; bj < 2; ++bj) {
                const size_t off = (size_t)row * ldx + col0 + bj * HALF;
                const f32x4 v0 = x[bj][0] + acc[ai][bj][m][0] * scale, v1 = x[bj][1] + acc[ai][bj][m][1] * scale;
                if (xout32) { *(f32x4*)(xout32 + off) = v0; *(f32x4*)(xout32 + off + 4) = v1; }
                u32x4 w; w.x = cvt_pk_bf16(v0[0], v0[1]); w.y = cvt_pk_bf16(v0[2], v0[3]); w.z = cvt_pk_bf16(v1[0], v1[1]); w.w = cvt_pk_bf16(v1[2], v1[3]);
                *(u32x4*)(xb + off) = w;
                if (wab) ab = __builtin_amdgcn_mfma_f32_16x16x32_bf16(wfr[bj], __builtin_bit_cast(bf16x8, w), ab, 0, 0, 0);
                { typedef float f2 __attribute__((ext_vector_type(2)));
                  const f2 a = {v0[0], v0[1]}, b2 = {v0[2], v0[3]}, c = {v1[0], v1[1]}, d = {v1[2], v1[3]}; f2 q = a * a; q = b2 * b2 + q; q = c * c + q; q = d * d + q; ss += q.x + q.y; }
            }
            ss += __shfl_xor(ss, 16); ss += __shfl_xor(ss, 32);
            if (fq == 0) ssq_out[(size_t)row * 16 + u.pn * 4 + wc] = ss;
            if (wab && fq < 2) *(f32x4*)(abp + (size_t)row * 128 + (u.pn * 4 + wc) * 8 + 4 * fq) = ab;
        };
        if (xin32) {
#pragma unroll
            for (int ai = 0; ai < 2; ++ai) {
#pragma unroll
                for (int mh = 0; mh < 2; ++mh) {
                    f32x4 xi[2][2][2];
#pragma unroll
                    for (int m = 0; m < 2; ++m)
#pragma unroll
                        for (int bj = 0; bj < 2; ++bj) { const float* p = xin32 + (size_t)(row0 + ai * HALF + (2 * mh + m) * 16) * ldx + col0 + bj * HALF; xi[m][bj][0] = *(const f32x4*)p; xi[m][bj][1] = *(const f32x4*)(p + 4); }
#pragma unroll
                    for (int m = 0; m < 2; ++m) finish(ai, 2 * mh + m, xi[m]);
                }
            }
        } else {
#pragma unroll
            for (int ai = 0; ai < 2; ++ai) {
                u32x4 xo[4][2];
#pragma unroll
                for (int m = 0; m < 4; ++m)
#pragma unroll
                    for (int bj = 0; bj < 2; ++bj) xo[m][bj] = *(const u32x4*)(xb + (size_t)(row0 + ai * HALF + m * 16) * ldx + col0 + bj * HALF);
#pragma unroll
                for (int m = 0; m < 4; ++m) {
                    f32x4 x[2][2];
#pragma unroll
                    for (int bj = 0; bj < 2; ++bj) { const u32x4 o = xo[m][bj];
                        x[bj][0] = (f32x4){__builtin_bit_cast(float, o.x << 16), __builtin_bit_cast(float, o.x & 0xffff0000u), __builtin_bit_cast(float, o.y << 16), __builtin_bit_cast(float, o.y & 0xffff0000u)};
                        x[bj][1] = (f32x4){__builtin_bit_cast(float, o.z << 16), __builtin_bit_cast(float, o.z & 0xffff0000u), __builtin_bit_cast(float, o.w << 16), __builtin_bit_cast(float, o.w & 0xffff0000u)}; }
                    finish(ai, m, x);
                }
            }
        }
    }
};
struct EpiFinal {
    static constexpr bool PERM = true, AFTER_DRAIN = false;
    float* out; const bf16_t* xb; float* part; unsigned* cnt; const float* gain; int ldx; float scale; unsigned* tmo;
    __device__ __forceinline__ void operator()(f32x4 (&acc)[2][2][4][2], const Unit& u, int wr, int wc, int fr, int fq) const {
        const int row0 = u.pm * BM + wr * 64 + fr, col0 = u.pn * BM + wc * 32 + 8 * fq;
#pragma unroll
        for (int ai = 0; ai < 2; ++ai) {
            u32x4 xo[4][2];
#pragma unroll
            for (int m = 0; m < 4; ++m)
#pragma unroll
                for (int bj = 0; bj < 2; ++bj) xo[m][bj] = *(const u32x4*)(xb + (size_t)(row0 + ai * HALF + m * 16) * ldx + col0 + bj * HALF);
#pragma unroll
            for (int m = 0; m < 4; ++m) {
                const int row = row0 + ai * HALF + m * 16;
                float ss = 0.f;
#pragma unroll
                for (int bj = 0; bj < 2; ++bj) {
                    const u32x4 o = xo[m][bj];
                    const f32x4 x0 = {__builtin_bit_cast(float, o.x << 16), __builtin_bit_cast(float, o.x & 0xffff0000u), __builtin_bit_cast(float, o.y << 16), __builtin_bit_cast(float, o.y & 0xffff0000u)};
                    const f32x4 x1 = {__builtin_bit_cast(float, o.z << 16), __builtin_bit_cast(float, o.z & 0xffff0000u), __builtin_bit_cast(float, o.w << 16), __builtin_bit_cast(float, o.w & 0xffff0000u)};
                    const f32x4 v0 = x0 + acc[ai][bj][m][0] * scale, v1 = x1 + acc[ai][bj][m][1] * scale;
                    acc[ai][bj][m][0] = v0; acc[ai][bj][m][1] = v1;
                    { typedef float f2 __attribute__((ext_vector_type(2)));
                      const f2 a = {v0[0], v0[1]}, b2 = {v0[2], v0[3]}, c = {v1[0], v1[1]}, d = {v1[2], v1[3]}; f2 q = a * a; q = b2 * b2 + q; q = c * c + q; q = d * d + q; ss += q.x + q.y; }
                }
                ss += __shfl_xor(ss, 16); ss += __shfl_xor(ss, 32);
                if (fq == 0) asm volatile("global_store_dword %0, %1, off sc1\n\ts_nop 1" :: "v"(part + (size_t)row * 16 + u.pn * 4 + wc), "v"(ss) : "memory");
            }
        }
        asm volatile("s_waitcnt vmcnt(0)" ::: "memory");
        __builtin_amdgcn_s_barrier();
        if (wr == 0 && wc == 0 && fr == 0 && fq == 0) {
            unsigned* c = cnt + 64 * u.pm; __hip_atomic_fetch_add(c, 1u, __ATOMIC_RELAXED, __HIP_MEMORY_SCOPE_AGENT);
            unsigned sp = 0;
            while (__hip_atomic_load(c, __ATOMIC_RELAXED, __HIP_MEMORY_SCOPE_AGENT) < 4u) { __builtin_amdgcn_s_sleep(1); if (++sp > (1u << 22)) { __hip_atomic_store(tmo, 1u, __ATOMIC_RELAXED, __HIP_MEMORY_SCOPE_AGENT); break; } }
        }
        __builtin_amdgcn_s_barrier();
        f32x4 g[2][2];
#pragma unroll
        for (int bj = 0; bj < 2; ++bj) { g[bj][0] = *(const f32x4*)(gain + col0 + bj * HALF); g[bj][1] = *(const f32x4*)(gain + col0 + bj * HALF + 4); }
#pragma unroll
        for (int ai = 0; ai < 2; ++ai) {
            f32x4 p0, p1, p2, p3; const float* pa = part + (size_t)(row0 + ai * HALF) * 16 + 4 * fq;
            asm volatile("global_load_dwordx4 %0, %4, off sc1\n\tglobal_load_dwordx4 %1, %4, off offset:1024 sc1\n\tglobal_load_dwordx4 %2, %4, off offset:2048 sc1\n\tglobal_load_dwordx4 %3, %4, off offset:3072 sc1\n\ts_waitcnt vmcnt(0)"
                         : "=&v"(p0), "=&v"(p1), "=&v"(p2), "=&v"(p3) : "v"(pa) : "memory");
#pragma unroll
            for (int m = 0; m < 4; ++m) {
                const f32x4 p = m == 0 ? p0 : m == 1 ? p1 : m == 2 ? p2 : p3;
                float s = (p.x + p.y) + (p.z + p.w); s += __shfl_xor(s, 16); s += __shfl_xor(s, 32);
                const float rstd = __builtin_amdgcn_rsqf(s * (1.f / 1024.f) + RMS_EPS);
                const int row = row0 + ai * HALF + m * 16;
#pragma unroll
                for (int bj = 0; bj < 2; ++bj) { float* op = out + (size_t)row * ldx + col0 + bj * HALF;
                    *(f32x4*)op = acc[ai][bj][m][0] * rstd * g[bj][0]; *(f32x4*)(op + 4) = acc[ai][bj][m][1] * rstd * g[bj][1]; }
            }
        }
    }
};

template <class Epi, class Sched, bool ALIGN_EPI = false, bool SP2 = false>
__device__ __forceinline__ void gemm_phase(PG8_LAS unsigned char* lds, const Gemm g, const Sched& S, const Epi& E) {
    int tid_ = threadIdx.x; asm volatile("" : "+v"(tid_));
    const int tid = tid_, wid = __builtin_amdgcn_readfirstlane(tid >> 6), lane = tid & 63, wr = wid >> 2, wc = wid & 3, fr = lane & 15, fq = lane >> 4;
    const int K = g.K, nt = K / BK, lda = g.lda;
    unsigned voffA[2], voffB[2];
#pragma unroll
    for (int i = 0; i < 2; ++i) { int R, C; stage_rc(tid * 16 + i * 8192, R, C); const int Rb = Epi::PERM ? ((R & ~31) + perm32(R & 31)) : R;
        voffA[i] = (unsigned)(R * lda + C) * 2u; voffB[i] = (unsigned)(Rb * K + C) * 2u; }
    const size_t kstep = (size_t)(BK * 2);
    const size_t hstepA = (size_t)HALF * lda * 2, hstepB = (size_t)HALF * K * 2;
    const size_t tstepA = 2 * hstepA, tstepB = 2 * hstepB;
    const unsigned ldsw = (unsigned)wid * 1024u;
    const int aoff = lds_byte(wr * 64 + fr, fq * 8), boff = lds_byte(wc * 32 + fr, fq * 8);
#define PG8_SA(b, h) (((b) * 2 + (h)) * HTB)
#define PG8_SB(b, h) ((4 + (b) * 2 + (h)) * HTB)
#define PG8_STAGE(bufoff, gbase, voff) do { _Pragma("unroll") for (int _i = 0; _i < 2; ++_i) \
        __builtin_amdgcn_global_load_lds((const unsigned*)((const char*)(gbase) + (voff)[_i]), (PG8_LAS unsigned*)(lds + (bufoff) + ldsw + _i * 8192), 16, 0, 0); } while (0)
#define PG8_LDA(dst, b, h) do { _Pragma("unroll") for (int m = 0; m < 4; ++m) _Pragma("unroll") for (int k = 0; k < 2; ++k) dst[m][k] = *(const PG8_LAS bf16x8*)(lds + PG8_SA(b, h) + aoff + m * 2048 + k * 1024); } while (0)
#define PG8_LDB(dst, b, h) do { _Pragma("unroll") for (int n = 0; n < 2; ++n) _Pragma("unroll") for (int k = 0; k < 2; ++k) dst[n][k] = *(const PG8_LAS bf16x8*)(lds + PG8_SB(b, h) + boff + n * 2048 + k * 1024); } while (0)
#define PG8_MMA(ai, bj, At, Bt) do { __builtin_amdgcn_s_setprio(1); _Pragma("unroll") for (int m = 0; m < 4; ++m) _Pragma("unroll") for (int n = 0; n < 2; ++n) _Pragma("unroll") for (int k = 0; k < 2; ++k) \
        acc[ai][bj][m][n] = __builtin_amdgcn_mfma_f32_16x16x32_bf16(Bt[n][k], At[m][k], acc[ai][bj][m][n], 0, 0, 0); __builtin_amdgcn_s_setprio(0); } while (0)
#define PG8_WAIT_V(n) asm volatile("s_waitcnt vmcnt(" #n ")" ::: "memory")
#define PG8_WAIT_L(n) asm volatile("s_waitcnt lgkmcnt(" #n ")" ::: "memory")
#define PG8_BAR __builtin_amdgcn_s_barrier()
#define PG8_SCHED __builtin_amdgcn_sched_barrier(0)
    Unit cur, nxt; int ui = 0;
    if (!S.next(0, cur)) return;
    f32x4 acc[2][2][4][2];
#pragma unroll
    for (int a = 0; a < 2; ++a)
#pragma unroll
        for (int b = 0; b < 2; ++b)
#pragma unroll
            for (int m = 0; m < 4; ++m)
#pragma unroll
                for (int n = 0; n < 2; ++n) acc[a][b][m][n] = (f32x4){0.f, 0.f, 0.f, 0.f};
    bf16x8 At[4][2], B0[2][2], B1[2][2];
    const char* cA = (const char*)g.A + (size_t)cur.pm * tstepA; const char* cB = (const char*)g.Bt + (size_t)cur.pn * tstepB;
    S.a_ready(cur);
    if constexpr (SP2) {
        PG8_STAGE(PG8_SB(0, 0), cB, voffB); PG8_STAGE(PG8_SB(0, 1), cB + hstepB, voffB); PG8_STAGE(PG8_SA(0, 0), cA, voffA); PG8_STAGE(PG8_SA(0, 1), cA + hstepA, voffA);
        if (wr == 1) PG8_BAR;
        PG8_WAIT_V(2); PG8_BAR;
        PG8_STAGE(PG8_SB(1, 0), cB + kstep, voffB); PG8_STAGE(PG8_SA(1, 0), cA + kstep, voffA); PG8_STAGE(PG8_SB(1, 1), cB + hstepB + kstep, voffB);
        PG8_WAIT_V(6); PG8_BAR;
    } else {
        PG8_STAGE(PG8_SB(0, 0), cB, voffB); PG8_STAGE(PG8_SA(0, 0), cA, voffA); PG8_STAGE(PG8_SB(0, 1), cB + hstepB, voffB); PG8_STAGE(PG8_SA(0, 1), cA + hstepA, voffA);
        if (wr == 1) PG8_BAR;
        PG8_WAIT_V(4); PG8_BAR;
        PG8_STAGE(PG8_SB(1, 0), cB + kstep, voffB); PG8_STAGE(PG8_SA(1, 0), cA + kstep, voffA); PG8_STAGE(PG8_SB(1, 1), cB + hstepB + kstep, voffB);
        PG8_WAIT_V(6); PG8_BAR;
    }
    for (;;) {
        const bool has_next = S.next(ui + 1, nxt);
        const char* nA = has_next ? (const char*)g.A + (size_t)nxt.pm * tstepA : cA; const char* nB = has_next ? (const char*)g.Bt + (size_t)nxt.pn * tstepB : cB;
        for (int t = 0; t < nt; t += 2) {
            const bool last = (t == nt - 2);
            const char* a1 = cA + (size_t)(t + 1) * kstep;
            const char* a2 = last ? nA : cA + (size_t)(t + 2) * kstep; const char* b2 = last ? nB : cB + (size_t)(t + 2) * kstep;
            const char* a3 = a2 + kstep; const char* b3 = b2 + kstep;
            if (last && has_next) S.a_ready(nxt);
            if constexpr (SP2) {
            PG8_LDB(B0, 0, 0); PG8_LDB(B1, 0, 1); PG8_SCHED; PG8_LDA(At, 0, 0); PG8_STAGE(PG8_SA(1, 1), a1 + hstepA, voffA);
            PG8_WAIT_V(8); PG8_WAIT_L(0); PG8_BAR; PG8_MMA(0, 0, At, B0); PG8_MMA(0, 1, At, B1); PG8_BAR; PG8_SCHED;
            PG8_LDA(At, 0, 1); PG8_STAGE(PG8_SB(0, 0), b2, voffB); PG8_STAGE(PG8_SB(0, 1), b2 + hstepB, voffB); PG8_STAGE(PG8_SA(0, 0), a2, voffA);
            PG8_WAIT_V(8); PG8_WAIT_L(0); PG8_BAR; PG8_MMA(1, 0, At, B0); PG8_MMA(1, 1, At, B1); PG8_BAR; PG8_SCHED;
            PG8_LDB(B0, 1, 0); PG8_LDB(B1, 1, 1); PG8_SCHED; PG8_LDA(At, 1, 0); PG8_STAGE(PG8_SA(0, 1), a2 + hstepA, voffA);
            PG8_WAIT_V(8); PG8_WAIT_L(0); PG8_BAR; PG8_MMA(0, 0, At, B0); PG8_MMA(0, 1, At, B1); PG8_BAR; PG8_SCHED;
            PG8_LDA(At, 1, 1); PG8_STAGE(PG8_SB(1, 0), b3, voffB); PG8_STAGE(PG8_SB(1, 1), b3 + hstepB, voffB); PG8_STAGE(PG8_SA(1, 0), a3, voffA);
            PG8_WAIT_V(8); PG8_WAIT_L(0); PG8_BAR; PG8_MMA(1, 0, At, B0); PG8_MMA(1, 1, At, B1); PG8_BAR; PG8_SCHED;
            } else {
            PG8_LDB(B0, 0, 0); PG8_SCHED; PG8_LDA(At, 0, 0); PG8_STAGE(PG8_SA(1, 1), a1 + hstepA, voffA);
            PG8_WAIT_L(8); PG8_BAR; PG8_WAIT_L(0); PG8_MMA(0, 0, At, B0); PG8_BAR; PG8_SCHED;
            PG8_LDB(B1, 0, 1); PG8_STAGE(PG8_SB(0, 0), b2, voffB);
            PG8_BAR; PG8_WAIT_L(0); PG8_MMA(0, 1, At, B1); PG8_BAR;
            PG8_LDA(At, 0, 1); PG8_STAGE(PG8_SA(0, 0), a2, voffA);
            PG8_BAR; PG8_WAIT_L(0); PG8_MMA(1, 0, At, B0); PG8_BAR; PG8_SCHED;
            PG8_STAGE(PG8_SB(0, 1), b2 + hstepB, voffB);
            PG8_WAIT_V(6); PG8_BAR; PG8_MMA(1, 1, At, B1); PG8_BAR;
            PG8_LDB(B0, 1, 0); PG8_SCHED; PG8_LDA(At, 1, 0); PG8_STAGE(PG8_SA(0, 1), a2 + hstepA, voffA);
            PG8_WAIT_L(8); PG8_BAR; PG8_WAIT_L(0); PG8_MMA(0, 0, At, B0); PG8_BAR; PG8_SCHED;
            PG8_LDB(B1, 1, 1); PG8_STAGE(PG8_SB(1, 0), b3, voffB);
            PG8_BAR; PG8_WAIT_L(0); PG8_MMA(0, 1, At, B1); PG8_BAR;
            PG8_LDA(At, 1, 1); PG8_STAGE(PG8_SA(1, 0), a3, voffA);
            PG8_BAR; PG8_WAIT_L(0); PG8_MMA(1, 0, At, B0); PG8_BAR; PG8_SCHED;
            PG8_STAGE(PG8_SB(1, 1), b3 + hstepB, voffB);
            PG8_WAIT_V(6); PG8_BAR; PG8_MMA(1, 1, At, B1); PG8_BAR;
            }
        }
        if constexpr (ALIGN_EPI) { if (wr == 0) PG8_BAR; }
        if constexpr (!Epi::AFTER_DRAIN) { E(acc, cur, wr, wc, fr, fq); S.done(cur); }
        if (!has_next) break;
#pragma unroll
        for (int a = 0; a < 2; ++a)
#pragma unroll
            for (int b = 0; b < 2; ++b)
#pragma unroll
                for (int m = 0; m < 4; ++m)
#pragma unroll
                    for (int n = 0; n < 2; ++n) acc[a][b][m][n] = (f32x4){0.f, 0.f, 0.f, 0.f};
        cur = nxt; cA = nA; cB = nB; ++ui;
        if constexpr (ALIGN_EPI) { if (wr == 1) PG8_BAR; }
    }
    PG8_WAIT_V(0);
    if constexpr (!ALIGN_EPI) { if (wr == 0) PG8_BAR; }
    PG8_BAR;
#undef PG8_SA
#undef PG8_SB
#undef PG8_STAGE
#undef PG8_LDA
#undef PG8_LDB
#undef PG8_MMA
#undef PG8_WAIT_V
#undef PG8_WAIT_L
#undef PG8_BAR
#undef PG8_SCHED
}
}

#ifndef DIAG
#define DIAG 0
#endif
#ifndef HGRN_CHUNKED
#define HGRN_CHUNKED 1
#endif
#ifndef RET_CHUNKED
#define RET_CHUNKED 1
#endif
#ifndef GDN_CHUNKED
#define GDN_CHUNKED 1
#endif
#ifndef DIAG_A
#define DIAG_A 4
#define DIAG_B 1
#endif
constexpr int NWAVES = 8, NTHR = NWAVES * 64;
constexpr int BATCH = 16, SEQ = 2048, DM = 1024, DEPTH = 4, NH = 4;
constexpr int M = BATCH * SEQ;
constexpr int DFF = 2816, NFI = 2 * DFF;
constexpr int NMIX_G = 3584;
constexpr int NMIX_SRC = 3592, NMIX = 3840;
constexpr int CHUNK = 64, NCHUNK = SEQ / CHUNK;
constexpr float EPS = 1e-6f;
constexpr int C_AQ = 0, C_BQ = 256, C_CQ = 512, C_DQK = 768, C_AF = 1024, C_AI = 1280, C_AG = 1536, C_BK = 1792, C_BV = 2048, C_BG = 2304,
              C_CK = 2560, C_CV = 2816, C_DV = 3072, C_DG = 3328, C_BA = 3584, C_BB = 3588, C_GB = 3600;
constexpr int Y_A = 0, Y_B = 256, Y_C = 512, Y_D = 768;
constexpr int XB_Q = 0, XB_K = 256, XB_V = 512, XB_GB = 768;

constexpr size_t MiB = 1u << 20;
constexpr size_t WS_CTL = 0, CTL_ZERO_BYTES = 192 * 1024;
constexpr size_t WS_ROPE = 1 * MiB;
constexpr size_t WS_SSQ = 2 * MiB;
constexpr size_t WS_W = 4 * MiB;
constexpr size_t W_FI = (size_t)NFI * DM * 2, W_FO = (size_t)DM * DFF * 2, W_MI = (size_t)NMIX * DM * 2, W_MO = (size_t)DM * DM * 2;
constexpr size_t WL_FI1 = 0, WL_FO1 = WL_FI1 + W_FI, WL_FI2 = WL_FO1 + W_FO, WL_FO2 = WL_FI2 + W_FI, WL_MI = WL_FO2 + W_FO, WL_MO = WL_MI + W_MI, WL_BYTES = WL_MO + W_MO;
constexpr size_t WS_XB = 176 * MiB;
constexpr size_t WS_BIG = 240 * MiB;
constexpr size_t WS_GDN = 480 * MiB;
constexpr size_t WS_END = 512 * MiB;
constexpr size_t OUT_ABP = 64 * MiB;
static_assert(WS_W + DEPTH * WL_BYTES <= WS_XB && WS_XB + (size_t)M * DM * 2 <= WS_BIG && WS_BIG + (size_t)M * NMIX * 2 <= WS_END, "d_ws map");
constexpr int CW_TMO = 0, CW_CODE = 1;
constexpr int CW_BAR = 4096;
constexpr int CW_QUEUE = 8192;
constexpr int CW_FIN = 32768;
constexpr int CW_GDN = 16384;
static_assert((size_t)(CW_FIN + 64 * (M / 256)) * 4 <= CTL_ZERO_BYTES && (size_t)(CW_QUEUE + 64 * DEPTH) * 4 <= CTL_ZERO_BYTES && (size_t)(CW_GDN + 64 * 64 * DEPTH) * 4 <= CTL_ZERO_BYTES && WS_SSQ + (size_t)M * 16 * 4 <= WS_W, "CTL words inside the memset region");

constexpr int RING_OFF = 0, RING_BYTES = 139264;
constexpr int LDSCTL_OFF = RING_BYTES, MISC_OFF = LDSCTL_OFF + 320;
constexpr int RS_OFF = RING_BYTES + 1024;
constexpr int LDS_BYTES = 147456;
static_assert(RS_OFF + 4096 <= LDS_BYTES, "LDS map");

#define GAS __attribute__((address_space(1)))
#define LAS __attribute__((address_space(3)))
typedef unsigned short bf16;
typedef unsigned v4u __attribute__((ext_vector_type(4)));
typedef float f32x4 __attribute__((ext_vector_type(4)));
typedef float f32x2 __attribute__((ext_vector_type(2)));
typedef GAS unsigned gu32;
#define RLX_AGENT __ATOMIC_RELAXED, __HIP_MEMORY_SCOPE_AGENT
#define LDS_WAIT() asm volatile("s_waitcnt lgkmcnt(0)" ::: "memory")
#define LDS_BARRIER() asm volatile("s_waitcnt lgkmcnt(0)\n\ts_barrier" ::: "memory")
#define VM_WAIT() asm volatile("s_waitcnt vmcnt(0)" ::: "memory")
typedef __bf16 bf16x2_t __attribute__((ext_vector_type(2)));
__device__ __forceinline__ unsigned pk2(float lo, float hi) { f32x2 v = {lo, hi}; bf16x2_t b = __builtin_convertvector(v, bf16x2_t); return __builtin_bit_cast(unsigned, b); }
__device__ __forceinline__ unsigned f2bf(float f) { return pk2(f, 0.f) & 0xffffu; }
__device__ __forceinline__ float bflo(unsigned u) { return __builtin_bit_cast(float, u << 16); }
__device__ __forceinline__ float bfhi(unsigned u) { return __builtin_bit_cast(float, u & 0xffff0000u); }
__device__ __forceinline__ float fexp(float x) { return __builtin_amdgcn_exp2f(x * 1.4426950408889634f); }
__device__ __forceinline__ float fsigmoid(float x) { return __builtin_amdgcn_rcpf(1.f + fexp(-x)); }
__device__ __forceinline__ float fsilu(float x) { return x * fsigmoid(x); }

#define XB_TMO      128
#define XB_XCNT(j)  (256  + 64 * (j))
#define XB_XSUB(j)  (1280 + 64 * (j))
#define XB_XGEN(j)  (2304 + 64 * (j))
#define XB_TOP      3328
#define XB_TOPGEN   3392
#define XCD_BAR_WORDS 3456
#define XB_SPIN_CAP (1u << 20)

__device__ __forceinline__ unsigned xb_ld(unsigned* p)              { return __hip_atomic_load(p, __ATOMIC_RELAXED, __HIP_MEMORY_SCOPE_AGENT); }
__device__ __forceinline__ unsigned xb_add(unsigned* p, unsigned v) { return __hip_atomic_fetch_add(p, v, __ATOMIC_RELAXED, __HIP_MEMORY_SCOPE_AGENT); }
__device__ __forceinline__ unsigned xb_xcc_id() { return (unsigned)__builtin_amdgcn_s_getreg((3 << 11) | 20) & 0xFu; }
#define XB_SPIN(cond, bar) do { unsigned _sp = 0; while (cond) { __builtin_amdgcn_s_sleep(1); \
    if ((++_sp & 255u) == 0u) { if (xb_ld(&(bar)[XB_TMO])) break; if (_sp > XB_SPIN_CAP) { atomicAdd(&(bar)[XB_TMO], 1u); break; } } } } while (0)

struct XcdBarrier {
    unsigned* bar; unsigned x;
    volatile LAS unsigned* st;
};
__device__ __forceinline__ XcdBarrier xcd_barrier_post(unsigned* bar, volatile LAS unsigned* st) {
    XcdBarrier b; b.bar = bar; b.x = xb_xcc_id(); b.st = st;
    if (threadIdx.x == 0) (void)xb_add(&bar[XB_XCNT(b.x)], 1u);
    return b;
}
__device__ __forceinline__ void xcd_barrier_complete(unsigned* bar, unsigned x, unsigned& nloc, unsigned& nx) {
    const unsigned G = gridDim.x * gridDim.y * gridDim.z;
    unsigned sum, cnt, mine, sp = 0u;
    for (;;) {
        sum = 0u; cnt = 0u; mine = 0u;
#pragma unroll
        for (unsigned j = 0; j < 16; ++j) { const unsigned c = xb_ld(&bar[XB_XCNT(j)]); sum += c; cnt += (c > 0u) ? 1u : 0u; mine = (j == x) ? c : mine; }
        if (sum == G) break;
        __builtin_amdgcn_s_sleep(1);
        if ((++sp & 255u) == 0u) { if (xb_ld(&bar[XB_TMO])) break; if (sp > XB_SPIN_CAP) { atomicAdd(&bar[XB_TMO], 1u); break; } }
    }
    nloc = mine > 0u ? mine : 1u; nx = cnt > 0u ? cnt : 1u;
}
__device__ __forceinline__ void xcd_barrier(const XcdBarrier& b) {
    asm volatile("s_waitcnt vmcnt(0)" ::: "memory");
    __syncthreads();
    if (threadIdx.x == 0) {
        unsigned* bar = b.bar;
        __builtin_amdgcn_s_waitcnt(0);
        unsigned nloc = b.st[0], nx = b.st[1];
        if (nloc == 0u) { xcd_barrier_complete(bar, b.x, nloc, nx); b.st[0] = nloc; b.st[1] = nx; }
        const unsigned old = xb_add(&bar[XB_XSUB(b.x)], 1u);
        const unsigned gen = old / nloc;
        if (old + 1u == (gen + 1u) * nloc) {
            __builtin_amdgcn_fence(__ATOMIC_RELEASE, "agent");
            asm volatile("s_waitcnt vmcnt(0)" ::: "memory");
            const unsigned og = xb_add(&bar[XB_TOP], 1u);
            const unsigned tg = og / nx;
            if (og + 1u == (tg + 1u) * nx) xb_add(&bar[XB_TOPGEN], 1u);
            else XB_SPIN(xb_ld(&bar[XB_TOPGEN]) == tg, bar);
            __builtin_amdgcn_fence(__ATOMIC_ACQUIRE, "agent");
            xb_add(&bar[XB_XGEN(b.x)], 1u);
            asm volatile("s_waitcnt vmcnt(0)" ::: "memory");
        } else {
            XB_SPIN(xb_ld(&bar[XB_XGEN(b.x)]) == gen, bar);
            __builtin_amdgcn_fence(__ATOMIC_ACQUIRE, "agent");
            asm volatile("s_waitcnt vmcnt(0)" ::: "memory");
        }
    }
    __syncthreads();
}

struct Frame {
    LAS unsigned char* lds;
    volatile LAS unsigned* MISC;
    gu32* ctl;
    int vcu, G;
};
__device__ __forceinline__ float wave_sum(float v) {
#pragma unroll
    for (int o = 1; o < 64; o <<= 1) v += __shfl_xor(v, o);
    return v;
}
template <int CTRL> __device__ __forceinline__ float dppf(float x) { return __builtin_bit_cast(float, __builtin_amdgcn_update_dpp(0, __builtin_bit_cast(int, x), CTRL, 0xF, 0xF, true)); }
__device__ __forceinline__ float red8(float x) {
    x += dppf<0xB1>(x);
    x += dppf<0x4E>(x);
    x += dppf<0x141>(x);
    return x;
}

#define OPAQUE_TID() int tid = threadIdx.x; asm volatile("" : "+v"(tid)); const int lane = tid & 63, wave = __builtin_amdgcn_readfirstlane(tid >> 6); (void)lane; (void)wave
__device__ __forceinline__ int mix_src_col(int j0) {
    const int seg = j0 >> 8, r = j0 & 255;
    if (seg == 3) { const int h = r >> 6, part = (r >> 5) & 1; return (part ? 2952 : 2824) + 32 * h; }
    if (seg == 14) return r == 0 ? -2 : -1;
    const int base = seg == 0 ? 0 : seg == 1 ? 1024 : seg == 2 ? 2056 : seg == 4 ? 256 : seg == 5 ? 512 : seg == 6 ? 768 : seg == 7 ? 1280 : seg == 8 ? 1536 :
                     seg == 9 ? 1792 : seg == 10 ? 2312 : seg == 11 ? 2568 : seg == 12 ? 3080 : 3336;
    return base + r;
}
__device__ __forceinline__ void transpose_item(const float* W, int K, int Nsrc, const float* gain, bf16* WT, int k0, int n0, int srccol, int nvalid, LAS float* scr, int lane) {
    const int nl = lane & 31;
    float wv[32];
#pragma unroll
    for (int i = 0; i < 32; ++i) { const int kk = 2 * i + (lane >> 5); wv[i] = (nl < nvalid) ? W[(size_t)(k0 + kk) * Nsrc + srccol + nl] : 0.f; }
    if (gain) {
#pragma unroll
        for (int i = 0; i < 32; ++i) wv[i] *= gain[k0 + 2 * i + (lane >> 5)]; }
#pragma unroll
    for (int i = 0; i < 32; ++i) scr[(2 * i + (lane >> 5)) * 33 + nl] = wv[i];
    LDS_WAIT(); asm volatile("" ::: "memory");
    const int c = lane & 7;
#pragma unroll
    for (int j = 0; j < 4; ++j) { const int n = (lane >> 3) + 8 * j; const LAS float* s = scr + (8 * c) * 33 + n;
        v4u o; o.x = pk2(s[0 * 33], s[1 * 33]); o.y = pk2(s[2 * 33], s[3 * 33]); o.z = pk2(s[4 * 33], s[5 * 33]); o.w = pk2(s[6 * 33], s[7 * 33]);
        *(GAS v4u*)(WT + (size_t)(n0 + n) * K + k0 + 8 * c) = o; }
    LDS_WAIT(); asm volatile("" ::: "memory");
}

struct Args { const float* in[19]; float* out; unsigned char* ws; int ph_lo, ph_hi; };
enum { I_X = 0, I_F1N, I_F1WI, I_F1WO, I_MN, I_MWI, I_MWO, I_F2N, I_F2WI, I_F2WO, I_LB, I_HGN, I_CONV, I_ALOG, I_DTB, I_GDN, I_SBN, I_RETN, I_FN };

constexpr int IT_FI = (DM / 64) * (NFI / 32), IT_FO = (DFF / 64) * (DM / 32), IT_MI = (DM / 64) * (NMIX / 32), IT_MO = (DM / 64) * (DM / 32);
constexpr int IT_LAYER = 2 * IT_FI + 2 * IT_FO + IT_MI + IT_MO;
__device__ __forceinline__ void convert_item(const Args& a, int l, int r, LAS float* scr, int lane) {
    bf16* wl = (bf16*)(a.ws + WS_W + (size_t)l * WL_BYTES);
    if (r < 2 * IT_FI) {
        const int half = r / IT_FI; r %= IT_FI;
        const int nb = r % (NFI / 32), kb = r / (NFI / 32), j0 = 32 * nb, pn = j0 >> 8, within = j0 & 255;
        const int src = within < 128 ? 128 * pn + within : DFF + 128 * pn + (within - 128);
        transpose_item((half ? a.in[I_F2WI] : a.in[I_F1WI]) + (size_t)l * DM * NFI, DM, NFI, (half ? a.in[I_F2N] : a.in[I_F1N]) + l * DM,
                       (bf16*)((char*)wl + (half ? WL_FI2 : WL_FI1)), 64 * kb, j0, src, 32, scr, lane);
        return; }
    r -= 2 * IT_FI;
    if (r < 2 * IT_FO) {
        const int half = r / IT_FO; r %= IT_FO;
        const int nb = r % (DM / 32), kb = r / (DM / 32);
        transpose_item((half ? a.in[I_F2WO] : a.in[I_F1WO]) + (size_t)l * DFF * DM, DFF, DM, nullptr, (bf16*)((char*)wl + (half ? WL_FO2 : WL_FO1)), 64 * kb, 32 * nb, 32 * nb, 32, scr, lane);
        return; }
    r -= 2 * IT_FO;
    if (r < IT_MI) {
        const int nb = r % (NMIX / 32), kb = r / (NMIX / 32), j0 = 32 * nb; int src = mix_src_col(j0), nv = 32;
        if (src == -1) { src = 0; nv = 0; } else if (src == -2) { src = 2048; nv = 8; }
        transpose_item(a.in[I_MWI] + (size_t)l * DM * NMIX_SRC, DM, NMIX_SRC, a.in[I_MN] + l * DM, (bf16*)((char*)wl + WL_MI), 64 * kb, j0, src, nv, scr, lane);
        return; }
    r -= IT_MI;
    { const int nb = r % (DM / 32), kb = r / (DM / 32);
      transpose_item(a.in[I_MWO] + (size_t)l * DM * DM, DM, DM, nullptr, (bf16*)((char*)wl + WL_MO), 64 * kb, 32 * nb, 32 * nb, 32, scr, lane); }
}
constexpr int CONV_UNITS = 256;
__device__ __forceinline__ void convert_unit(Frame& F, const Args& a, int l, int cu) {
    OPAQUE_TID();
    LAS float* scr = (LAS float*)(F.lds + RING_OFF + wave * 16384);
    for (int it = cu * NWAVES + wave; it < IT_LAYER; it += CONV_UNITS * NWAVES) convert_item(a, l, it, scr, lane);
    __syncthreads();
}
__device__ __forceinline__ void p0_prologue(Frame& F, const Args& a) {
    OPAQUE_TID();
    LAS float* scr = (LAS float*)(F.lds + RING_OFF + wave * 16384);
    const int gw = F.vcu * NWAVES + wave, NGW = F.G * NWAVES;
    for (int it = gw; it < IT_LAYER; it += NGW) convert_item(a, 0, it, scr, lane);
    {
        const float* x = a.in[I_X]; bf16* xb = (bf16*)(a.ws + WS_XB); float* ssq0 = (float*)(a.ws + WS_SSQ);
        for (int m0 = gw; m0 < M; m0 += 4 * NGW) {
            f32x4 v[4][4];
#pragma unroll
            for (int r = 0; r < 4; ++r) { const int m = m0 + r * NGW;
                if (m < M) { const GAS f32x4* xr = (const GAS f32x4*)(x + (size_t)m * DM) + lane;
#pragma unroll
                    for (int j = 0; j < 4; ++j) v[r][j] = xr[64 * j]; } }
#pragma unroll
            for (int r = 0; r < 4; ++r) { const int m = m0 + r * NGW;
                if (m < M) {
                    float s = 0.f;
#pragma unroll
                    for (int j = 0; j < 4; ++j) s += (v[r][j].x * v[r][j].x + v[r][j].y * v[r][j].y) + (v[r][j].z * v[r][j].z + v[r][j].w * v[r][j].w);
                    s = wave_sum(s);
                    GAS unsigned long long* o8 = (GAS unsigned long long*)(xb + (size_t)m * DM) + lane;
#pragma unroll
                    for (int j = 0; j < 4; ++j) o8[64 * j] = (unsigned long long)pk2(v[r][j].x, v[r][j].y) | ((unsigned long long)pk2(v[r][j].z, v[r][j].w) << 32);
                    if (lane < 16) ssq0[(size_t)m * 16 + lane] = lane == 0 ? s : 0.f; } }
        }
    }
    {
        f32x2* rope = (f32x2*)(a.ws + WS_ROPE);
        for (int e = (F.vcu * NTHR + tid); e < SEQ * 16; e += F.G * NTHR) {
            const int t = e >> 4, i = e & 15;
            double invf = 1.0; for (int q = 0; q < i; ++q) invf *= 0.56234132519034907;
            const double ang = (double)t * invf;
            const double nq = __builtin_rint(ang * 0.63661977236758138);
            double r = __builtin_fma(-nq, 1.5707963267948966, ang); r = __builtin_fma(-nq, 6.123233995736766e-17, r);
            const double r2 = r * r;
            double sp = -1.0 / 6227020800.0; sp = sp * r2 + 1.0 / 39916800.0; sp = sp * r2 - 1.0 / 362880.0; sp = sp * r2 + 1.0 / 5040.0; sp = sp * r2 - 1.0 / 120.0; sp = sp * r2 + 1.0 / 6.0;
            const double sn = r - r * r2 * sp;
            double cp = 1.0 / 87178291200.0; cp = cp * r2 - 1.0 / 479001600.0; cp = cp * r2 + 1.0 / 3628800.0; cp = cp * r2 - 1.0 / 40320.0; cp = cp * r2 + 1.0 / 720.0; cp = cp * r2 - 1.0 / 24.0; cp = cp * r2 + 0.5;
            const double cs = 1.0 - r2 * cp;
            const int qd = ((int)nq) & 3;
            const double s_out = qd == 0 ? sn : qd == 1 ? cs : qd == 2 ? -sn : -cs;
            const double c_out = qd == 0 ? cs : qd == 1 ? -sn : qd == 2 ? -cs : sn;
            rope[e] = (f32x2){(float)c_out, (float)s_out};
        }
    }
}

struct MixCtx { bf16* proj; int l; const Args* a; bf16* yb; int ldy; };

__device__ __forceinline__ void ld8bf(const bf16* p, float (&o)[8]) {
    const v4u u = *(const GAS v4u*)p;
    o[0] = bflo(u.x); o[1] = bfhi(u.x); o[2] = bflo(u.y); o[3] = bfhi(u.y); o[4] = bflo(u.z); o[5] = bfhi(u.z); o[6] = bflo(u.w); o[7] = bfhi(u.w);
}
__device__ __forceinline__ void st8f(LAS float* p, const float (&v)[8]) { *(LAS f32x4*)p = (f32x4){v[0], v[1], v[2], v[3]}; *(LAS f32x4*)(p + 4) = (f32x4){v[4], v[5], v[6], v[7]}; }
__device__ __forceinline__ void ld8f(const LAS float* p, float (&v)[8]) { const f32x4 a = *(const LAS f32x4*)p, b = *(const LAS f32x4*)(p + 4); v[0] = a.x; v[1] = a.y; v[2] = a.z; v[3] = a.w; v[4] = b.x; v[5] = b.y; v[6] = b.z; v[7] = b.w; }

__device__ __forceinline__ void up8bf(const v4u& u, float (&o)[8]) { o[0] = bflo(u.x); o[1] = bfhi(u.x); o[2] = bflo(u.y); o[3] = bfhi(u.y); o[4] = bflo(u.z); o[5] = bfhi(u.z); o[6] = bflo(u.w); o[7] = bfhi(u.w); }
template <int GATE>
__device__ __forceinline__ void scan_epilogue(const LAS float* obuf, const v4u& gu, bf16* yb, int ldy, size_t row, int ycol, const float* ng, int t, int c) {
    float o[8]; ld8f(obuf + t * 64 + 8 * c, o);
    float ss = 0.f;
#pragma unroll
    for (int e = 0; e < 8; ++e) ss += o[e] * o[e];
    ss = red8(ss);
    const float rstd = __builtin_amdgcn_rsqf(ss * (1.f / 64.f) + EPS);
    float g[8]; up8bf(gu, g);
    float y[8];
#pragma unroll
    for (int e = 0; e < 8; ++e) y[e] = o[e] * rstd * ng[8 * c + e] * (GATE == 0 ? fsigmoid(g[e]) : fsilu(g[e]));
    v4u w; w.x = pk2(y[0], y[1]); w.y = pk2(y[2], y[3]); w.z = pk2(y[4], y[5]); w.w = pk2(y[6], y[7]);
    *(GAS v4u*)(yb + row * ldy + ycol + 8 * c) = w;
}
struct F8 { f32x2 a, b, c, d; };
__device__ __forceinline__ F8 ldF8(const LAS float* p) { const f32x4 x = *(const LAS f32x4*)p, y = *(const LAS f32x4*)(p + 4); F8 r; r.a = (f32x2){x.x, x.y}; r.b = (f32x2){x.z, x.w}; r.c = (f32x2){y.x, y.y}; r.d = (f32x2){y.z, y.w}; return r; }
__device__ __forceinline__ float dotF8(const F8& k, const F8& s) { f32x2 p = k.a * s.a; p = k.b * s.b + p; p = k.c * s.c + p; p = k.d * s.d + p; return p.x + p.y; }
__device__ __forceinline__ float dot8(const float (&a)[8], const float (&b)[8]) { return ((a[0] * b[0] + a[1] * b[1]) + (a[2] * b[2] + a[3] * b[3])) + ((a[4] * b[4] + a[5] * b[5]) + (a[6] * b[6] + a[7] * b[7])); }

__device__ __forceinline__ void scan_hgrn2(Frame& F, const MixCtx& X, int b, int h) {
    OPAQUE_TID();
    LAS float* qs = (LAS float*)(F.lds + RING_OFF); LAS float* fs = qs + 4096; LAS float* is = fs + 4096; LAS float* obuf = is + 4096;
    const int t = tid >> 3, c = tid & 7, vl = lane >> 3, kg = lane & 7, v = 8 * wave + vl;
    float lb[8];
    { const float* lg = X.a->in[I_LB];
#pragma unroll
      for (int e = 0; e < 8; ++e) { const int ch = h * 64 + 8 * c + e; const float x0 = lg[ch], x1 = lg[256 + ch], x2 = lg[512 + ch], x3 = lg[768 + ch];
          const float mx = fmaxf(fmaxf(x0, x1), fmaxf(x2, x3)); const float e0 = fexp(x0 - mx), e1 = fexp(x1 - mx), e2 = fexp(x2 - mx), e3 = fexp(x3 - mx);
          const float inv = 1.f / (e0 + e1 + e2 + e3); const float c1 = e1 * inv, c2 = c1 + e2 * inv, c3 = c2 + e3 * inv;
          lb[e] = X.l == 0 ? 0.f : X.l == 1 ? c1 : X.l == 2 ? c2 : c3; } }
    const float* ng = X.a->in[I_HGN] + X.l * 256 + h * 64;
    F8 S; S.a = S.b = S.c = S.d = (f32x2){0.f, 0.f};
    const bf16* base = X.proj + ((size_t)b * SEQ + t) * NMIX + h * 64 + 8 * c;
    v4u rq = *(const GAS v4u*)(base + C_AQ), rf = *(const GAS v4u*)(base + C_AF), ri = *(const GAS v4u*)(base + C_AI), rg = *(const GAS v4u*)(base + C_AG);
    for (int n = 0; n < NCHUNK; ++n) {
        const size_t row = (size_t)b * SEQ + n * CHUNK + t;
        { float q[8], f[8], iv[8]; up8bf(rq, q); up8bf(rf, f); up8bf(ri, iv);
#pragma unroll
          for (int e = 0; e < 8; ++e) { q[e] = fsilu(q[e]); f[e] = lb[e] + (1.f - lb[e]) * fsigmoid(f[e]); iv[e] = fsilu(iv[e]); }
          st8f(qs + t * 64 + 8 * c, q); st8f(fs + t * 64 + 8 * c, f); st8f(is + t * 64 + 8 * c, iv); }
        const v4u gcur = rg;
        LDS_BARRIER();
        if (n + 1 < NCHUNK) { const bf16* nb = base + (size_t)(n + 1) * CHUNK * NMIX;
            rq = *(const GAS v4u*)(nb + C_AQ); rf = *(const GAS v4u*)(nb + C_AF); ri = *(const GAS v4u*)(nb + C_AI); rg = *(const GAS v4u*)(nb + C_AG); }
        F8 f8 = ldF8(fs + 8 * kg), q8 = ldF8(qs + 8 * kg); float iv = is[v];
#pragma unroll 8
        for (int s = 0; s < CHUNK; ++s) {
            const int sn = (s + 1) & (CHUNK - 1);
            const F8 f8n = ldF8(fs + sn * 64 + 8 * kg), q8n = ldF8(qs + sn * 64 + 8 * kg); const float ivn = is[sn * 64 + v];
            const f32x2 iv2 = {iv, iv};
            S.a = f8.a * (S.a - iv2) + iv2; S.b = f8.b * (S.b - iv2) + iv2; S.c = f8.c * (S.c - iv2) + iv2; S.d = f8.d * (S.d - iv2) + iv2;
            const float po = red8(dotF8(q8, S));
            obuf[s * 64 + v] = po;
            f8 = f8n; q8 = q8n; iv = ivn;
        }
        LDS_BARRIER();
        scan_epilogue<0>(obuf, gcur, X.yb, X.ldy, row, Y_A + h * 64, ng, t, c);
    }
    __syncthreads();
}

__device__ __forceinline__ void scan_retention(Frame& F, const MixCtx& X, int b, int h) {
    OPAQUE_TID();
    LAS float* qs = (LAS float*)(F.lds + RING_OFF); LAS float* ks = qs + 2048; LAS float* vs = ks + 2048; LAS float* obuf = vs + 4096;
    const int t = tid >> 3, c = tid & 7, vl = lane >> 3, kg = lane & 7, v = 8 * wave + vl;
    const float gamma = 1.f - __builtin_amdgcn_exp2f(-5.f - (float)h);
    const float* ng = X.a->in[I_RETN] + X.l * 256 + h * 64;
    const f32x2* rope = (const f32x2*)(X.a->ws + WS_ROPE);
    float S[4] = {0.f, 0.f, 0.f, 0.f};
    const bf16* base = X.proj + ((size_t)b * SEQ + t) * NMIX + h * 64 + 8 * c;
    v4u rx = *(const GAS v4u*)(base + C_DQK), rv = *(const GAS v4u*)(base + C_DV), rg = *(const GAS v4u*)(base + C_DG);
    const int i0 = 8 * (c & 1); const bool hi = (c & 2) != 0; const float sc = c >= 4 ? 0.17677669529663687f : 1.f;
    for (int n = 0; n < NCHUNK; ++n) {
        const int tpos = n * CHUNK + t; const size_t row = (size_t)b * SEQ + tpos;
        {
          float x[8], p[8]; up8bf(rx, x);
#pragma unroll
          for (int e = 0; e < 8; ++e) p[e] = __shfl_xor(x[e], 2);
          float o[8];
#pragma unroll
          for (int e = 0; e < 8; ++e) { const f32x2 cs = rope[tpos * 16 + i0 + e];
              o[e] = (hi ? (p[e] * cs.y + x[e] * cs.x) : (x[e] * cs.x - p[e] * cs.y)) * sc; }
          LAS float* dst = (c < 4 ? qs : ks) + t * 32 + 8 * (c & 3); st8f(dst, o);
          float vv[8]; up8bf(rv, vv); st8f(vs + t * 64 + 8 * c, vv); }
        const v4u gcur = rg;
        LDS_BARRIER();
        if (n + 1 < NCHUNK) { const bf16* nb = base + (size_t)(n + 1) * CHUNK * NMIX; rx = *(const GAS v4u*)(nb + C_DQK); rv = *(const GAS v4u*)(nb + C_DV); rg = *(const GAS v4u*)(nb + C_DG); }
        f32x4 k4 = *(const LAS f32x4*)(ks + 4 * kg), q4 = *(const LAS f32x4*)(qs + 4 * kg); float vv = vs[v];
#pragma unroll 8
        for (int s = 0; s < CHUNK; ++s) {
            const int sn = (s + 1) & (CHUNK - 1);
            const f32x4 k4n = *(const LAS f32x4*)(ks + sn * 32 + 4 * kg), q4n = *(const LAS f32x4*)(qs + sn * 32 + 4 * kg); const float vvn = vs[sn * 64 + v];
            S[0] = gamma * S[0] + k4.x * vv; S[1] = gamma * S[1] + k4.y * vv; S[2] = gamma * S[2] + k4.z * vv; S[3] = gamma * S[3] + k4.w * vv;
            const float po = red8((q4.x * S[0] + q4.y * S[1]) + (q4.z * S[2] + q4.w * S[3]));
            obuf[s * 64 + v] = po;
            k4 = k4n; q4 = q4n; vv = vvn;
        }
        LDS_BARRIER();
        scan_epilogue<1>(obuf, gcur, X.yb, X.ldy, row, Y_D + h * 64, ng, t, c);
    }
    __syncthreads();
}

__device__ __forceinline__ void scan_gdn(Frame& F, const MixCtx& X, int b, int h) {
    OPAQUE_TID();
    LAS float* qs = (LAS float*)(F.lds + RING_OFF); LAS float* ks = qs + 4096; LAS float* vs = ks + 4096; LAS float* obuf = vs + 4096;
    LAS float* ab = obuf + 4096;
    LAS float* cw = ab + 128;
    LAS bf16* raw = (LAS bf16*)(cw + 768);
    const int t = tid >> 3, c = tid & 7, vl = lane >> 3, kg = lane & 7, v = 8 * wave + vl;
    const float* ng = X.a->in[I_GDN] + X.l * 256 + h * 64;
    const float a_exp = fexp(X.a->in[I_ALOG][X.l * 4 + h]), dtb = X.a->in[I_DTB][X.l * 4 + h];
    { const float* w = X.a->in[I_CONV] + (size_t)X.l * 4 * 768;
      for (int i = tid; i < 768; i += NTHR) { const int g = i >> 8, j = (i >> 6) & 3, ch = i & 63; cw[i] = w[j * 768 + g * 256 + h * 64 + ch]; }
      for (int i = tid; i < 3 * 3 * 64; i += NTHR) { const int g = i / 192, r = (i % 192) >> 6, ch = i & 63; raw[(g * 67 + r) * 64 + ch] = 0; } }
    F8 S; S.a = S.b = S.c = S.d = (f32x2){0.f, 0.f};
    const bf16* base = X.proj + ((size_t)b * SEQ + t) * NMIX + h * 64 + 8 * c;
    const bf16* abase = X.proj + ((size_t)b * SEQ + (tid & 63)) * NMIX + h;
    v4u rq = *(const GAS v4u*)(base + C_BQ), rk = *(const GAS v4u*)(base + C_BK), rv = *(const GAS v4u*)(base + C_BV), rg = *(const GAS v4u*)(base + C_BG);
    unsigned ra = 0, rb = 0; if (tid < 64) { ra = abase[C_BA]; rb = abase[C_BB]; }
    __syncthreads();
    for (int n = 0; n < NCHUNK; ++n) {
        const size_t row = (size_t)b * SEQ + n * CHUNK + t;
        *(LAS v4u*)(raw + (0 * 67 + 3 + t) * 64 + 8 * c) = rq; *(LAS v4u*)(raw + (1 * 67 + 3 + t) * 64 + 8 * c) = rk; *(LAS v4u*)(raw + (2 * 67 + 3 + t) * 64 + 8 * c) = rv;
        if (tid < 64) { const float z = bflo(ra) + dtb; const float sp = fmaxf(z, 0.f) + __builtin_amdgcn_logf(1.f + fexp(-fabsf(z))) * 0.6931471805599453f;
            ab[2 * tid] = fexp(-a_exp * sp); ab[2 * tid + 1] = fsigmoid(bflo(rb)); }
        const v4u gcur = rg;
        LDS_BARRIER();
        if (n + 1 < NCHUNK) { const bf16* nb = base + (size_t)(n + 1) * CHUNK * NMIX;
            rq = *(const GAS v4u*)(nb + C_BQ); rk = *(const GAS v4u*)(nb + C_BK); rv = *(const GAS v4u*)(nb + C_BV); rg = *(const GAS v4u*)(nb + C_BG);
            if (tid < 64) { const bf16* na = abase + (size_t)(n + 1) * CHUNK * NMIX; ra = na[C_BA]; rb = na[C_BB]; } }
        {
          float y[3][8];
#pragma unroll
          for (int g = 0; g < 3; ++g) {
#pragma unroll
              for (int e = 0; e < 8; ++e) y[g][e] = 0.f;
#pragma unroll
              for (int j = 0; j < 4; ++j) { const v4u u = *(const LAS v4u*)(raw + (g * 67 + t + j) * 64 + 8 * c); float w8[8]; ld8f(cw + (g * 4 + j) * 64 + 8 * c, w8);
                  y[g][0] += bflo(u.x) * w8[0]; y[g][1] += bfhi(u.x) * w8[1]; y[g][2] += bflo(u.y) * w8[2]; y[g][3] += bfhi(u.y) * w8[3];
                  y[g][4] += bflo(u.z) * w8[4]; y[g][5] += bfhi(u.z) * w8[5]; y[g][6] += bflo(u.w) * w8[6]; y[g][7] += bfhi(u.w) * w8[7]; }
#pragma unroll
              for (int e = 0; e < 8; ++e) y[g][e] = fsilu(y[g][e]); }
          float sq = 0.f, sk = 0.f;
#pragma unroll
          for (int e = 0; e < 8; ++e) { sq += y[0][e] * y[0][e]; sk += y[1][e] * y[1][e]; }
          sq = red8(sq); sk = red8(sk);
          const float rq_ = __builtin_amdgcn_rsqf(sq + EPS) * 0.125f, rk_ = __builtin_amdgcn_rsqf(sk + EPS);
#pragma unroll
          for (int e = 0; e < 8; ++e) { y[0][e] *= rq_; y[1][e] *= rk_; }
          st8f(qs + t * 64 + 8 * c, y[0]); st8f(ks + t * 64 + 8 * c, y[1]); st8f(vs + t * 64 + 8 * c, y[2]); }
        LDS_BARRIER();
        if (tid < 3 * 3 * 8) { const int g = tid / 24, r = (tid % 24) >> 3, cc = tid & 7;
            *(LAS v4u*)(raw + (g * 67 + r) * 64 + 8 * cc) = *(const LAS v4u*)(raw + (g * 67 + 64 + r) * 64 + 8 * cc); }
        F8 k8 = ldF8(ks + 8 * kg), q8 = ldF8(qs + 8 * kg); float vv = vs[v]; f32x2 abv = *(const LAS f32x2*)ab;
#pragma unroll 8
        for (int s = 0; s < CHUNK; ++s) {
            const int sn = (s + 1) & (CHUNK - 1);
            const F8 k8n = ldF8(ks + sn * 64 + 8 * kg), q8n = ldF8(qs + sn * 64 + 8 * kg); const float vvn = vs[sn * 64 + v]; const f32x2 abn = *(const LAS f32x2*)(ab + 2 * sn);
            const float pk = red8(dotF8(k8, S));
            const float d = abv.y * (vv - abv.x * pk);
            const f32x2 d2 = {d, d}, al2 = {abv.x, abv.x};
            S.a = al2 * S.a + k8.a * d2; S.b = al2 * S.b + k8.b * d2; S.c = al2 * S.c + k8.c * d2; S.d = al2 * S.d + k8.d * d2;
            const float po = red8(dotF8(q8, S));
            obuf[s * 64 + v] = po;
            k8 = k8n; q8 = q8n; vv = vvn; abv = abn;
        }
        LDS_BARRIER();
        scan_epilogue<1>(obuf, gcur, X.yb, X.ldy, row, Y_B + h * 64, ng, t, c);
    }
    __syncthreads();
}

typedef float f32x16 __attribute__((ext_vector_type(16)));
typedef short bf16x8 __attribute__((ext_vector_type(8)));
typedef short s16x4 __attribute__((ext_vector_type(4)));
__device__ __forceinline__ unsigned cvtpk(float lo, float hi) { return pk2(lo, hi); }
__device__ __forceinline__ void swap32(float& a, float& b) { asm volatile("s_nop 1\n\tv_permlane32_swap_b32 %0, %1\n\ts_nop 1" : "+v"(a), "+v"(b)); }
constexpr int SB_KBUF = 8192, SB_VROW = 144, SB_VBUF = 64 * SB_VROW, SB_STAGE = SB_KBUF + SB_VBUF;
__device__ __forceinline__ int sb_voff(int d, int key) { return d * SB_VROW + ((((key >> 3) ^ (d >> 3)) & 7) << 4) + (key & 7) * 2; }
constexpr float SB_C2 = 0.125f * 1.4426950408889634f;
__device__ __forceinline__ void sb_write_tile(LAS unsigned char* buf, const v4u& kr, const v4u& vr, int skey, int sc) {
    *(LAS v4u*)(buf + skey * 128 + ((sc ^ ((skey >> 1) & 7)) << 4)) = kr;
    LAS unsigned char* vt = buf + SB_KBUF;
    *(LAS unsigned short*)(vt + sb_voff(8 * sc + 0, skey)) = (unsigned short)vr.x; *(LAS unsigned short*)(vt + sb_voff(8 * sc + 1, skey)) = (unsigned short)(vr.x >> 16);
    *(LAS unsigned short*)(vt + sb_voff(8 * sc + 2, skey)) = (unsigned short)vr.y; *(LAS unsigned short*)(vt + sb_voff(8 * sc + 3, skey)) = (unsigned short)(vr.y >> 16);
    *(LAS unsigned short*)(vt + sb_voff(8 * sc + 4, skey)) = (unsigned short)vr.z; *(LAS unsigned short*)(vt + sb_voff(8 * sc + 5, skey)) = (unsigned short)(vr.z >> 16);
    *(LAS unsigned short*)(vt + sb_voff(8 * sc + 6, skey)) = (unsigned short)vr.w; *(LAS unsigned short*)(vt + sb_voff(8 * sc + 7, skey)) = (unsigned short)(vr.w >> 16);
}
__device__ __forceinline__ void sb_unit(Frame& F, const MixCtx& X, int b, int h, int qb) {
    OPAQUE_TID();
    LAS unsigned char* L = F.lds + RING_OFF;
    const int ql = lane & 31, hh = lane >> 5;
    const size_t rowq = (size_t)b * SEQ + 256 * qb + 32 * wave + ql;
    bf16x8 qf[4];
#pragma unroll
    for (int s = 0; s < 4; ++s) { const v4u u = *(const GAS v4u*)(X.proj + rowq * NMIX + C_CQ + h * 64 + 16 * s + 8 * hh);
        v4u w; w.x = cvtpk(bflo(u.x) * SB_C2, bfhi(u.x) * SB_C2); w.y = cvtpk(bflo(u.y) * SB_C2, bfhi(u.y) * SB_C2); w.z = cvtpk(bflo(u.z) * SB_C2, bfhi(u.z) * SB_C2); w.w = cvtpk(bflo(u.w) * SB_C2, bfhi(u.w) * SB_C2);
        qf[s] = __builtin_bit_cast(bf16x8, w); }
    f32x16 O0, O1;
#pragma unroll
    for (int i = 0; i < 16; ++i) { O0[i] = 0.f; O1[i] = 0.f; }
    float carry = 1.f;
    const int Tmax = 4 * qb + 3, wblk = 8 * qb + wave;
    const int skey = tid >> 3, sc = tid & 7;
    const bf16* kg = X.proj + (size_t)b * SEQ * NMIX + C_CK + h * 64 + 8 * sc;
    const bf16* vg = X.proj + (size_t)b * SEQ * NMIX + C_CV + h * 64 + 8 * sc;
    v4u kr = *(const GAS v4u*)(kg + (size_t)(64 * Tmax + skey) * NMIX), vr = *(const GAS v4u*)(vg + (size_t)(64 * Tmax + skey) * NMIX);
    sb_write_tile(L + (Tmax & 1) * SB_STAGE, kr, vr, skey, sc);
    LAS int* dflag = (LAS int*)(L + 2 * SB_STAGE);
    if (tid < 16) dflag[tid] = 0;
    for (int T = Tmax; T >= 0; --T) {
        __syncthreads();
        if (T < Tmax) { const LAS int* df = dflag + ((T + 1) & 1) * 8; if ((df[0] & df[1] & df[2] & df[3] & df[4] & df[5] & df[6] & df[7]) != 0) break; }
        if (T > 0) { kr = *(const GAS v4u*)(kg + (size_t)(64 * (T - 1) + skey) * NMIX); vr = *(const GAS v4u*)(vg + (size_t)(64 * (T - 1) + skey) * NMIX); }
        const LAS unsigned char* Kb = L + (T & 1) * SB_STAGE; const LAS unsigned char* Vb = Kb + SB_KBUF;
#pragma unroll
        for (int kb2 = 1; kb2 >= 0; --kb2) {
            const int blk = 2 * T + kb2;
            if (blk <= wblk) {
                f32x16 S;
#pragma unroll
                for (int i = 0; i < 16; ++i) S[i] = 0.f;
                const int key = 32 * kb2 + ql;
#pragma unroll
                for (int s = 0; s < 4; ++s) { const bf16x8 kf = *(const LAS bf16x8*)(Kb + key * 128 + (((2 * s + hh) ^ ((key >> 1) & 7)) << 4));
                    S = __builtin_amdgcn_mfma_f32_32x32x16_bf16(kf, qf[s], S, 0, 0, 0); }
                float r[16];
                const bool diag = (blk == wblk);
#pragma unroll
                for (int i = 0; i < 16; ++i) { const float e = __builtin_amdgcn_exp2f(S[i]); float ri = __builtin_amdgcn_rcpf(1.f + e);
                    if (diag) { const int kappa = (i & 3) + 8 * (i >> 2) + 4 * hh; ri = kappa < ql ? ri : 1.f; }
                    r[i] = ri; }
                float Hg[4], pt[4];
                { float G[4];
#pragma unroll
                  for (int g = 0; g < 4; ++g) { const float tot = (r[4 * g] * r[4 * g + 1]) * (r[4 * g + 2] * r[4 * g + 3]);
                      float t0 = tot, t1 = tot; swap32(t0, t1);
                      G[g] = t0 * t1; pt[g] = hh ? 1.f : t1; }
                  Hg[3] = carry; Hg[2] = Hg[3] * G[3]; Hg[1] = Hg[2] * G[2]; Hg[0] = Hg[1] * G[1]; carry = Hg[0] * G[0]; }
                float w[16];
#pragma unroll
                for (int g = 0; g < 4; ++g) { float run = Hg[g] * pt[g];
#pragma unroll
                    for (int i = 3; i >= 0; --i) { const float nr = run * r[4 * g + i]; w[4 * g + i] = run - nr; run = nr; } }
#pragma unroll
                for (int sp = 0; sp < 2; ++sp) {
                    v4u pw; pw.x = cvtpk(w[8 * sp], w[8 * sp + 1]); pw.y = cvtpk(w[8 * sp + 2], w[8 * sp + 3]); pw.z = cvtpk(w[8 * sp + 4], w[8 * sp + 5]); pw.w = cvtpk(w[8 * sp + 6], w[8 * sp + 7]);
                    const bf16x8 pf = __builtin_bit_cast(bf16x8, pw);
#pragma unroll
                    for (int dt = 0; dt < 2; ++dt) {
                        const s16x4 v0 = *(const LAS s16x4*)(Vb + sb_voff(32 * dt + ql, 32 * kb2 + 16 * sp + 4 * hh)), v1 = *(const LAS s16x4*)(Vb + sb_voff(32 * dt + ql, 32 * kb2 + 16 * sp + 8 + 4 * hh));
                        const bf16x8 vf = {v0[0], v0[1], v0[2], v0[3], v1[0], v1[1], v1[2], v1[3]};
                        if (dt == 0) O0 = __builtin_amdgcn_mfma_f32_32x32x16_bf16(vf, pf, O0, 0, 0, 0); else O1 = __builtin_amdgcn_mfma_f32_32x32x16_bf16(vf, pf, O1, 0, 0, 0); }
                }
            }
        }
        if (lane == 0) dflag[(T & 1) * 8 + wave] = (__ballot(carry != 0.f) == 0ull) ? 1 : 0;
        if (T > 0) sb_write_tile(L + ((T - 1) & 1) * SB_STAGE, kr, vr, skey, sc);
    }
    float ss = 0.f;
#pragma unroll
    for (int i = 0; i < 16; ++i) ss += O0[i] * O0[i] + O1[i] * O1[i];
    { float s0 = ss, s1 = ss; swap32(s0, s1); ss = s0 + s1; }
    const float rstd = __builtin_amdgcn_rsqf(ss * (1.f / 64.f) + EPS);
    const float* ng = X.a->in[I_SBN] + X.l * 256 + h * 64;
#pragma unroll
    for (int dt = 0; dt < 2; ++dt)
#pragma unroll
        for (int g = 0; g < 4; ++g) { const int d0 = 32 * dt + 8 * g + 4 * hh; const f32x4 gn = *(const f32x4*)(ng + d0);
            const float y0 = (dt ? O1[4 * g] : O0[4 * g]) * rstd * gn.x, y1 = (dt ? O1[4 * g + 1] : O0[4 * g + 1]) * rstd * gn.y, y2 = (dt ? O1[4 * g + 2] : O0[4 * g + 2]) * rstd * gn.z, y3 = (dt ? O1[4 * g + 3] : O0[4 * g + 3]) * rstd * gn.w;
            *(GAS f32x2*)(X.yb + rowq * X.ldy + Y_C + h * 64 + d0) = __builtin_bit_cast(f32x2, (unsigned long long)pk2(y0, y1) | ((unsigned long long)pk2(y2, y3) << 32)); }
    __syncthreads();
}

constexpr int GT_TR = 144;
constexpr int GO_QI = 0, GO_KI = 8192, GO_QS = 16384, GO_KG = 24576, GO_TT = 32768, GO_KT = 40960, GO_VR = GO_KT + 64 * GT_TR, GO_VT = GO_VR + 64 * GT_TR, GO_ST = GO_VT + 64 * GT_TR,
              GO_VEC = GO_ST + 64 * GT_TR, GO_CW = GO_VEC + 1024, GO_RAW = GO_CW + 3072, GO_END = GO_RAW + 3 * 67 * 128;
static_assert(GO_END <= RING_BYTES && GO_VEC % 16 == 0 && GO_RAW % 16 == 0, "GDN LDS map");
constexpr int GO_KB = GO_QS;
__device__ __forceinline__ bf16x8 frag_rm(const LAS unsigned char* X, int row, int s, int hh) { return *(const LAS bf16x8*)(X + row * 128 + (((2 * s + hh) ^ ((row >> 1) & 7)) << 4)); }
__device__ __forceinline__ int tr_off(int row, int tok) { return row * GT_TR + ((((tok >> 3) ^ (row >> 3)) & 7) << 4) + (tok & 7) * 2; }
__device__ __forceinline__ bf16x8 frag_tr(const LAS unsigned char* Y, int row, int s, int hh) { return *(const LAS bf16x8*)(Y + tr_off(row, 16 * s + 8 * hh)); }
__device__ __forceinline__ bf16x8 frag_tr_perm(const LAS unsigned char* Y, int row, int j0, int hh) {
    const s16x4 a = *(const LAS s16x4*)(Y + tr_off(row, j0 + 4 * hh)), b = *(const LAS s16x4*)(Y + tr_off(row, j0 + 8 + 4 * hh));
    return (bf16x8){a[0], a[1], a[2], a[3], b[0], b[1], b[2], b[3]}; }
__device__ __forceinline__ bf16x8 frag_rm_perm(const LAS unsigned char* X, int row, int j0, int hh) {
    const int sw = (row >> 1) & 7, c0 = j0 >> 3; const LAS unsigned char* r = X + row * 128 + 8 * hh;
    const s16x4 a = *(const LAS s16x4*)(r + ((c0 ^ sw) << 4)), b = *(const LAS s16x4*)(r + (((c0 + 1) ^ sw) << 4));
    return (bf16x8){a[0], a[1], a[2], a[3], b[0], b[1], b[2], b[3]}; }
struct TrLane { int xo[4]; int xh[2]; int o8; };
__device__ __forceinline__ TrLane tr_lane(int ql, int hh) { TrLane T; const int g = ql >> 3;
#pragma unroll
    for (int j = 0; j < 4; ++j) T.xo[j] = (j ^ g) << 4;
    T.xh[0] = (hh ^ g) << 4; T.xh[1] = ((2 + hh) ^ g) << 4; T.o8 = 8 * hh; return T; }
__device__ __forceinline__ bf16x8 frag_tr_x(const LAS unsigned char* Y, const TrLane& T, int row, int s) { return *(const LAS bf16x8*)(Y + row * GT_TR + ((((s >> 1) ^ (row >> 5)) & 1) << 6) + T.xh[s & 1]); }
__device__ __forceinline__ int tr_c4(const TrLane& T, int row, int tchi, int tl) { return row * GT_TR + T.o8 + (((tchi ^ (row >> 5)) & 1) << 6) + T.xo[tl]; }
__device__ __forceinline__ bf16x8 frag_tr_perm_x(const LAS unsigned char* Y, const TrLane& T, int row, int j0) {
    const s16x4 a = *(const LAS s16x4*)(Y + tr_c4(T, row, j0 >> 5, (j0 >> 3) & 3)), b = *(const LAS s16x4*)(Y + tr_c4(T, row, j0 >> 5, ((j0 >> 3) & 3) + 1));
    return (bf16x8){a[0], a[1], a[2], a[3], b[0], b[1], b[2], b[3]}; }
__device__ __forceinline__ bf16x8 pack8(float a0, float a1, float a2, float a3, float a4, float a5, float a6, float a7) {
    v4u w; w.x = cvtpk(a0, a1); w.y = cvtpk(a2, a3); w.z = cvtpk(a4, a5); w.w = cvtpk(a6, a7); return __builtin_bit_cast(bf16x8, w); }
__device__ __forceinline__ unsigned long long pack4(float a0, float a1, float a2, float a3) { return (unsigned long long)cvtpk(a0, a1) | ((unsigned long long)cvtpk(a2, a3) << 32); }
__device__ __forceinline__ v4u pk8bf(const float (&v)[8]) { v4u w; w.x = pk2(v[0], v[1]); w.y = pk2(v[2], v[3]); w.z = pk2(v[4], v[5]); w.w = pk2(v[6], v[7]); return w; }
__device__ __forceinline__ void st_rm(LAS unsigned char* X, int t, int c, const float (&v)[8]) { *(LAS v4u*)(X + t * 128 + ((c ^ ((t >> 1) & 7)) << 4)) = pk8bf(v); }
__device__ __forceinline__ void st_trT(LAS unsigned char* Y, int t, int c, const float (&v)[8]) {
#pragma unroll
    for (int e = 0; e < 8; ++e) *(LAS unsigned short*)(Y + tr_off(8 * c + e, t)) = (unsigned short)f2bf(v[e]); }

__device__ __forceinline__ void gdn_conv(const LAS bf16* raw, const LAS float* cw, int t, int c, float (&y)[3][8]) {
#pragma unroll
    for (int g = 0; g < 3; ++g) {
#pragma unroll
        for (int e = 0; e < 8; ++e) y[g][e] = 0.f;
#pragma unroll
        for (int j = 0; j < 4; ++j) { const v4u u = *(const LAS v4u*)(raw + (g * 67 + t + j) * 64 + 8 * c); float w8[8]; ld8f(cw + (g * 4 + j) * 64 + 8 * c, w8);
            y[g][0] += bflo(u.x) * w8[0]; y[g][1] += bfhi(u.x) * w8[1]; y[g][2] += bflo(u.y) * w8[2]; y[g][3] += bfhi(u.y) * w8[3];
            y[g][4] += bflo(u.z) * w8[4]; y[g][5] += bfhi(u.z) * w8[5]; y[g][6] += bflo(u.w) * w8[6]; y[g][7] += bfhi(u.w) * w8[7]; }
#pragma unroll
        for (int e = 0; e < 8; ++e) y[g][e] = fsilu(y[g][e]); }
    float sq = 0.f, sk = 0.f;
#pragma unroll
    for (int e = 0; e < 8; ++e) { sq += y[0][e] * y[0][e]; sk += y[1][e] * y[1][e]; }
    sq = red8(sq); sk = red8(sk);
    const float rq_ = __builtin_amdgcn_rsqf(sq + EPS) * 0.125f, rk_ = __builtin_amdgcn_rsqf(sk + EPS);
#pragma unroll
    for (int e = 0; e < 8; ++e) { y[0][e] *= rq_; y[1][e] *= rk_; }
}

__device__ __forceinline__ void gdn_prep(Frame& F, const MixCtx& X, int b, int h, int part) {
    constexpr int pass = 0; const int n0 = 8 * part;
    OPAQUE_TID();
    LAS unsigned char* L = F.lds + RING_OFF;
    LAS float* la = (LAS float*)(L + GO_VEC); LAS float* bet = la + 64; LAS float* gcs = la + 128;
    LAS float* cw = (LAS float*)(L + GO_CW); LAS bf16* raw = (LAS bf16*)(L + GO_RAW);
    const int t = tid >> 3, c = tid & 7, ql = lane & 31, hh = lane >> 5;
    const float* ng = X.a->in[I_GDN] + X.l * 256 + h * 64;
    const float a_exp = fexp(X.a->in[I_ALOG][X.l * 4 + h]), dtb = X.a->in[I_DTB][X.l * 4 + h];
    float* scratch = (float*)(X.a->ws + WS_GDN) + (size_t)(b * 4 + h) * (NCHUNK * 4096);
    const bf16* base = X.proj + ((size_t)b * SEQ + n0 * CHUNK + t) * NMIX + h * 64 + 8 * c;
    const float* abrow = (const float*)((const unsigned char*)X.a->out + OUT_ABP) + ((size_t)b * SEQ + n0 * CHUNK + t) * 128 + c * 8 + h;
    const float* sqrow = (const float*)(X.a->ws + WS_SSQ) + ((size_t)b * SEQ + n0 * CHUNK + t) * 16 + c;
    bf16* xbp = (bf16*)X.a->out;

    {
        { const float* w = X.a->in[I_CONV] + (size_t)X.l * 4 * 768;
          for (int i = tid; i < 768; i += NTHR) { const int g = i >> 8, j = (i >> 6) & 3, ch = i & 63; cw[i] = w[j * 768 + g * 256 + h * 64 + ch]; }
          if (tid < 3 * 3 * 8) { const int g = tid / 24, r = (tid % 24) >> 3, cc = tid & 7; v4u hv = {0u, 0u, 0u, 0u};
              if (n0 > 0) hv = *(const GAS v4u*)(X.proj + ((size_t)b * SEQ + n0 * CHUNK - 3 + r) * NMIX + (g == 0 ? C_BQ : g == 1 ? C_BK : C_BV) + h * 64 + 8 * cc);
              *(LAS v4u*)(raw + (g * 67 + r) * 64 + 8 * cc) = hv; }
          if (pass == 1) for (int i = tid; i < 64 * GT_TR / 4; i += NTHR) ((LAS unsigned*)(L + GO_ST))[i] = 0u; }
        v4u rq = *(const GAS v4u*)(base + C_BQ), rk = *(const GAS v4u*)(base + C_BK), rv = *(const GAS v4u*)(base + C_BV);
        float pa0 = abrow[0], pa1 = abrow[64], pb0 = abrow[4], pb1 = abrow[68], ps0 = sqrow[0], ps1 = sqrow[8];
        f32x16 Sacc;
#pragma unroll
        for (int i = 0; i < 16; ++i) Sacc[i] = 0.f;
        __syncthreads();
        for (int n = n0; n < n0 + 8; ++n) {
            *(LAS v4u*)(raw + (0 * 67 + 3 + t) * 64 + 8 * c) = rq; *(LAS v4u*)(raw + (1 * 67 + 3 + t) * 64 + 8 * c) = rk; *(LAS v4u*)(raw + (2 * 67 + 3 + t) * 64 + 8 * c) = rv;
            { const float sa = red8(pa0 + pa1), sb = red8(pb0 + pb1), rs = __builtin_amdgcn_rsqf(red8(ps0 + ps1) * (1.f / DM) + EPS);
              if (c == 0) { const float z = sa * rs + dtb; const float sp = fmaxf(z, 0.f) + __builtin_amdgcn_logf(1.f + fexp(-fabsf(z))) * 0.6931471805599453f;
                  la[t] = -a_exp * sp; bet[t] = fsigmoid(sb * rs); } }
            LDS_BARRIER();
            if (n + 1 < n0 + 8) { const bf16* nb = base + (size_t)(n + 1 - n0) * CHUNK * NMIX;
                rq = *(const GAS v4u*)(nb + C_BQ); rk = *(const GAS v4u*)(nb + C_BK); rv = *(const GAS v4u*)(nb + C_BV);
                { const float* na = abrow + (size_t)(n + 1 - n0) * CHUNK * 128; const float* ns = sqrow + (size_t)(n + 1 - n0) * CHUNK * 16;
                  pa0 = na[0]; pa1 = na[64]; pb0 = na[4]; pb1 = na[68]; ps0 = ns[0]; ps1 = ns[8]; } }
            v4u tt = {0u, 0u, 0u, 0u};
            if (pass == 1) tt = *(const GAS v4u*)((const bf16*)(scratch + (size_t)n * 4096) + t * 64 + 8 * c);
            float y[3][8];
            if (pass == 0) { gdn_conv(raw, cw, t, c, y);
                bf16* wb = xbp + ((size_t)b * SEQ + n * CHUNK + t) * DM + h * 64 + 8 * c;
                *(GAS v4u*)(wb + XB_Q) = pk8bf(y[0]); *(GAS v4u*)(wb + XB_K) = pk8bf(y[1]); *(GAS v4u*)(wb + XB_V) = pk8bf(y[2]); }
            else { const v4u u0 = *(const LAS v4u*)(raw + (0 * 67 + 3 + t) * 64 + 8 * c), u1 = *(const LAS v4u*)(raw + (1 * 67 + 3 + t) * 64 + 8 * c), u2 = *(const LAS v4u*)(raw + (2 * 67 + 3 + t) * 64 + 8 * c);
                up8bf(u0, y[0]); up8bf(u1, y[1]); up8bf(u2, y[2]); }
            if (tid < 64) { float x = la[tid];
#pragma unroll
                for (int d = 1; d < 64; d <<= 1) { const float o = __shfl_up(x, d); if (lane >= d) x += o; }
                gcs[tid] = x;
                *(GAS f32x2*)(xbp + ((size_t)b * SEQ + n * CHUNK + tid) * DM + XB_GB + 4 * h) = (f32x2){x, bet[tid]}; }
            LDS_BARRIER();
            if (tid < 3 * 3 * 8) { const int g = tid / 24, r = (tid % 24) >> 3, cc = tid & 7;
                *(LAS v4u*)(raw + (g * 67 + r) * 64 + 8 * cc) = *(const LAS v4u*)(raw + (g * 67 + 64 + r) * 64 + 8 * cc); }
            const float gct = gcs[t], glast = gcs[63], bt = bet[t];
            if (pass == 0) {
                float kb[8];
#pragma unroll
                for (int e = 0; e < 8; ++e) kb[e] = bt * y[1][e];
                st_rm(L + GO_KB, t, c, kb); st_rm(L + GO_KI, t, c, y[1]);
            } else {
                const float eg = fexp(gct), ek = fexp(glast - gct);
                float qs_[8], kg_[8], kt_[8];
#pragma unroll
                for (int e = 0; e < 8; ++e) { qs_[e] = y[0][e] * eg; kg_[e] = y[1][e] * eg; kt_[e] = y[1][e] * ek; }
                st_rm(L + GO_QI, t, c, y[0]); st_rm(L + GO_KI, t, c, y[1]); st_rm(L + GO_QS, t, c, qs_); st_rm(L + GO_KG, t, c, kg_);
                st_trT(L + GO_KT, t, c, kt_); st_trT(L + GO_VR, t, c, y[2]);
                *(LAS v4u*)(L + GO_TT + t * 128 + ((c ^ ((t >> 1) & 7)) << 4)) = tt;
            }
            LDS_BARRIER();
            if (pass == 0) {
                if (wave < 3) {
                    const int ab = wave == 0 ? 0 : 1, bb = wave == 2 ? 1 : 0;
                    f32x16 D;
#pragma unroll
                    for (int i = 0; i < 16; ++i) D[i] = 0.f;
#pragma unroll
                    for (int s = 0; s < 4; ++s) D = __builtin_amdgcn_mfma_f32_32x32x16_bf16(frag_rm(L + GO_KB, 32 * ab + ql, s, hh), frag_rm(L + GO_KI, 32 * bb + ql, s, hh), D, 0, 0, 0);
                    const float gcb = gcs[32 * bb + ql]; bf16* mt = (bf16*)(scratch + (size_t)n * 4096) + (32 * bb + ql) * 64 + 32 * ab;
#pragma unroll
                    for (int g = 0; g < 4; ++g) { const f32x4 ga = *(const LAS f32x4*)(gcs + 32 * ab + 8 * g + 4 * hh); f32x4 o;
#pragma unroll
                        for (int i = 0; i < 4; ++i) { const int a = 32 * ab + 8 * g + 4 * hh + i; o[i] = (a > 32 * bb + ql) ? D[4 * g + i] * fexp(ga[i] - gcb) : 0.f; }
                        *(GAS unsigned long long*)(mt + 8 * g + 4 * hh) = (unsigned long long)pk2(o[0], o[1]) | ((unsigned long long)pk2(o[2], o[3]) << 32); }
                }
            } else {
                if (wave < 4) {
                    const int tb = wave & 1, vb = wave >> 1;
                    f32x16 R0, R1;
#pragma unroll
                    for (int tb2 = 0; tb2 < 2; ++tb2) {
                        f32x16 ks;
#pragma unroll
                        for (int i = 0; i < 16; ++i) ks[i] = 0.f;
#pragma unroll
                        for (int s = 0; s < 4; ++s) ks = __builtin_amdgcn_mfma_f32_32x32x16_bf16(frag_rm(L + GO_KG, 32 * tb2 + ql, s, hh), frag_tr(L + GO_ST, 32 * vb + ql, s, hh), ks, 0, 0, 0);
#pragma unroll
                        for (int g = 0; g < 4; ++g) { const s16x4 vr = *(const LAS s16x4*)(L + GO_VR + tr_off(32 * vb + ql, 32 * tb2 + 8 * g + 4 * hh));
                            const f32x4 be = *(const LAS f32x4*)(bet + 32 * tb2 + 8 * g + 4 * hh);
#pragma unroll
                            for (int i = 0; i < 4; ++i) { const float r = be[i] * (__builtin_bit_cast(float, (unsigned)(unsigned short)vr[i] << 16) - ks[4 * g + i]); if (tb2 == 0) R0[4 * g + i] = r; else R1[4 * g + i] = r; } }
                    }
                    f32x16 vn;
#pragma unroll
                    for (int i = 0; i < 16; ++i) vn[i] = 0.f;
#pragma unroll
                    for (int sp = 0; sp < 2; ++sp) {
                        vn = __builtin_amdgcn_mfma_f32_32x32x16_bf16(frag_rm_perm(L + GO_TT, 32 * tb + ql, 16 * sp, hh), pack8(R0[8 * sp], R0[8 * sp + 1], R0[8 * sp + 2], R0[8 * sp + 3], R0[8 * sp + 4], R0[8 * sp + 5], R0[8 * sp + 6], R0[8 * sp + 7]), vn, 0, 0, 0);
                        vn = __builtin_amdgcn_mfma_f32_32x32x16_bf16(frag_rm_perm(L + GO_TT, 32 * tb + ql, 32 + 16 * sp, hh), pack8(R1[8 * sp], R1[8 * sp + 1], R1[8 * sp + 2], R1[8 * sp + 3], R1[8 * sp + 4], R1[8 * sp + 5], R1[8 * sp + 6], R1[8 * sp + 7]), vn, 0, 0, 0); }
#pragma unroll
                    for (int g = 0; g < 4; ++g) *(LAS unsigned long long*)(L + GO_VT + tr_off(32 * vb + ql, 32 * tb + 8 * g + 4 * hh)) = pack4(vn[4 * g], vn[4 * g + 1], vn[4 * g + 2], vn[4 * g + 3]);
                }
                LDS_BARRIER();
                if (wave < 2) {
                    const int tb = wave; const size_t row = (size_t)b * SEQ + n * CHUNK + 32 * tb + ql;
                    f32x16 O0, O1;
#pragma unroll
                    for (int i = 0; i < 16; ++i) { O0[i] = 0.f; O1[i] = 0.f; }
                    unsigned long long gq[8];
#pragma unroll
                    for (int dt = 0; dt < 2; ++dt)
#pragma unroll
                        for (int g = 0; g < 4; ++g) gq[dt * 4 + g] = *(const GAS unsigned long long*)(X.proj + row * NMIX + C_BG + h * 64 + 32 * dt + 8 * g + 4 * hh);
                    const float gctq = gcs[32 * tb + ql];
#pragma unroll
                    for (int sb = 0; sb < 2; ++sb) {
                        if (sb <= tb) {
                            f32x16 P;
#pragma unroll
                            for (int i = 0; i < 16; ++i) P[i] = 0.f;
#pragma unroll
                            for (int s = 0; s < 4; ++s) P = __builtin_amdgcn_mfma_f32_32x32x16_bf16(frag_rm(L + GO_KI, 32 * sb + ql, s, hh), frag_rm(L + GO_QI, 32 * tb + ql, s, hh), P, 0, 0, 0);
                            float w[16];
#pragma unroll
                            for (int g = 0; g < 4; ++g) { const f32x4 gs = *(const LAS f32x4*)(gcs + 32 * sb + 8 * g + 4 * hh);
#pragma unroll
                                for (int i = 0; i < 4; ++i) { const int sidx = 32 * sb + 8 * g + 4 * hh + i; w[4 * g + i] = (sidx <= 32 * tb + ql) ? P[4 * g + i] * fexp(gctq - gs[i]) : 0.f; } }
#pragma unroll
                            for (int sp = 0; sp < 2; ++sp) { const bf16x8 pf = pack8(w[8 * sp], w[8 * sp + 1], w[8 * sp + 2], w[8 * sp + 3], w[8 * sp + 4], w[8 * sp + 5], w[8 * sp + 6], w[8 * sp + 7]);
                                O0 = __builtin_amdgcn_mfma_f32_32x32x16_bf16(frag_tr_perm(L + GO_VT, ql, 32 * sb + 16 * sp, hh), pf, O0, 0, 0, 0);
                                O1 = __builtin_amdgcn_mfma_f32_32x32x16_bf16(frag_tr_perm(L + GO_VT, 32 + ql, 32 * sb + 16 * sp, hh), pf, O1, 0, 0, 0); }
                        }
                    }
#pragma unroll
                    for (int s = 0; s < 4; ++s) { const bf16x8 qf = frag_rm(L + GO_QS, 32 * tb + ql, s, hh);
                        O0 = __builtin_amdgcn_mfma_f32_32x32x16_bf16(frag_tr(L + GO_ST, ql, s, hh), qf, O0, 0, 0, 0);
                        O1 = __builtin_amdgcn_mfma_f32_32x32x16_bf16(frag_tr(L + GO_ST, 32 + ql, s, hh), qf, O1, 0, 0, 0); }
                    float ss = 0.f;
#pragma unroll
                    for (int i = 0; i < 16; ++i) ss += O0[i] * O0[i] + O1[i] * O1[i];
                    { float s0 = ss, s1 = ss; swap32(s0, s1); ss = s0 + s1; }
                    const float rstd = __builtin_amdgcn_rsqf(ss * (1.f / 64.f) + EPS);
#pragma unroll
                    for (int dt = 0; dt < 2; ++dt)
#pragma unroll
                        for (int g = 0; g < 4; ++g) { const int d0 = 32 * dt + 8 * g + 4 * hh; const f32x4 gn = *(const f32x4*)(ng + d0);
                            const unsigned glo = (unsigned)gq[dt * 4 + g], ghi = (unsigned)(gq[dt * 4 + g] >> 32);
                            const float y0 = (dt ? O1[4 * g] : O0[4 * g]) * rstd * gn.x * fsilu(bflo(glo)), y1 = (dt ? O1[4 * g + 1] : O0[4 * g + 1]) * rstd * gn.y * fsilu(bfhi(glo)),
                                        y2 = (dt ? O1[4 * g + 2] : O0[4 * g + 2]) * rstd * gn.z * fsilu(bflo(ghi)), y3 = (dt ? O1[4 * g + 3] : O0[4 * g + 3]) * rstd * gn.w * fsilu(bfhi(ghi));
                            *(GAS unsigned long long*)(X.yb + row * X.ldy + Y_B + h * 64 + d0) = (unsigned long long)pk2(y0, y1) | ((unsigned long long)pk2(y2, y3) << 32); }
                } else if (wave >= 4) {
                    const int kb = wave & 1, vb = (wave >> 1) & 1; const float el = fexp(gcs[63]);
#pragma unroll
                    for (int i = 0; i < 16; ++i) Sacc[i] *= el;
#pragma unroll
                    for (int s = 0; s < 4; ++s) Sacc = __builtin_amdgcn_mfma_f32_32x32x16_bf16(frag_tr(L + GO_KT, 32 * kb + ql, s, hh), frag_tr(L + GO_VT, 32 * vb + ql, s, hh), Sacc, 0, 0, 0);
                }
                LDS_BARRIER();
                if (wave >= 4) { const int kb = wave & 1, vb = (wave >> 1) & 1;
#pragma unroll
                    for (int g = 0; g < 4; ++g) *(LAS unsigned long long*)(L + GO_ST + tr_off(32 * vb + ql, 32 * kb + 8 * g + 4 * hh)) = pack4(Sacc[4 * g], Sacc[4 * g + 1], Sacc[4 * g + 2], Sacc[4 * g + 3]);
                }
            }
        }
        __syncthreads();
    }
    __syncthreads();
}

typedef short s16x4_t __attribute__((ext_vector_type(4)));
__device__ __forceinline__ s16x4_t pk4bf(float a, float b, float c, float d) { return __builtin_bit_cast(s16x4_t, (unsigned long long)pk2(a, b) | ((unsigned long long)pk2(c, d) << 32)); }
__device__ __forceinline__ void gdn_tpass(Frame& F, const MixCtx& X, int b, int h, int part) {
    OPAQUE_TID();
    LAS unsigned char* L = F.lds + RING_OFF;
    float* scratch = (float*)(X.a->ws + WS_GDN) + (size_t)(b * 4 + h) * (NCHUNK * 4096);
    LAS unsigned short* mT = (LAS unsigned short*)(L + wave * 16384);
    LAS unsigned short* TT = mT + 4096;
    const int n = 8 * part + wave; const float* gm = scratch + (size_t)n * 4096;
#pragma unroll
    for (int i = 0; i < 8; ++i) *(LAS v4u*)(mT + (i * 64 + lane) * 8) = *(const GAS v4u*)((const bf16*)gm + (i * 64 + lane) * 8);
#pragma unroll
    for (int cc = 0; cc < 8; ++cc) *(LAS v4u*)(TT + lane * 64 + 8 * cc) = (v4u){0u, 0u, 0u, 0u};
    const int bi = lane >> 4, r = lane & 15;
    float Dr[16];
#pragma unroll
    for (int cc = 0; cc < 16; ++cc) Dr[cc] = 0.f;
#pragma unroll
    for (int cc = 15; cc >= 0; --cc) {
        int z = 0; asm volatile("" : "+s"(z));
        if (z == 0) {
            const LAS unsigned short* mp = mT + (16 * bi + cc) * 64 + 16 * bi;
            const v4u u0 = *(const LAS v4u*)mp, u1 = *(const LAS v4u*)(mp + 8);
            float mv[16]; mv[0] = bflo(u0.x); mv[1] = bfhi(u0.x); mv[2] = bflo(u0.y); mv[3] = bfhi(u0.y); mv[4] = bflo(u0.z); mv[5] = bfhi(u0.z); mv[6] = bflo(u0.w); mv[7] = bfhi(u0.w);
            mv[8] = bflo(u1.x); mv[9] = bfhi(u1.x); mv[10] = bflo(u1.y); mv[11] = bfhi(u1.y); mv[12] = bflo(u1.z); mv[13] = bfhi(u1.z); mv[14] = bflo(u1.w); mv[15] = bfhi(u1.w);
            float a0 = (r == cc) ? 1.f : 0.f, a1 = 0.f;
#pragma unroll
            for (int j = cc + 1; j < 16; ++j) { if ((j - cc) & 1) a0 -= Dr[j] * mv[j]; else a1 -= Dr[j] * mv[j]; }
            Dr[cc] = a0 + a1;
        }
    }
    { LAS unsigned short* dp = TT + lane * 64 + 16 * bi;
      *(LAS v4u*)dp = (v4u){pk2(Dr[0], Dr[1]), pk2(Dr[2], Dr[3]), pk2(Dr[4], Dr[5]), pk2(Dr[6], Dr[7])};
      *(LAS v4u*)(dp + 8) = (v4u){pk2(Dr[8], Dr[9]), pk2(Dr[10], Dr[11]), pk2(Dr[12], Dr[13]), pk2(Dr[14], Dr[15])}; }
    {
        const int c16 = lane & 15, g = lane >> 4;
        auto ldA_m = [&](const int i, const int k) -> s16x4_t { const LAS unsigned short* p = mT + (16 * k + 4 * g) * 64 + 16 * i + c16;
            return (s16x4_t){(short)p[0], (short)p[64], (short)p[128], (short)p[192]}; };
        auto ldA_D = [&](const int i) -> s16x4_t { return *(const LAS s16x4_t*)(TT + (16 * i + c16) * 64 + 16 * i + 4 * g); };
        auto ldB_D = [&](const int j) -> s16x4_t { const LAS unsigned short* p = TT + (16 * j + 4 * g) * 64 + 16 * j + c16;
            return (s16x4_t){(short)p[0], (short)p[64], (short)p[128], (short)p[192]}; };
        auto mm = [&](const s16x4_t a, const s16x4_t bb, const f32x4 c) -> f32x4 { return __builtin_amdgcn_mfma_f32_16x16x16bf16_1k(a, bb, c, 0, 0, 0); };
        const f32x4 Z = {0.f, 0.f, 0.f, 0.f};
        auto fin = [&](const int i, const int j, const f32x4 S) -> s16x4_t {
            const f32x4 Tn = mm(ldA_D(i), pk4bf(S[0], S[1], S[2], S[3]), Z);
            const s16x4_t Tb = pk4bf(-Tn[0], -Tn[1], -Tn[2], -Tn[3]);
            LAS unsigned short* p = TT + (16 * i + 4 * g) * 64 + 16 * j + c16;
            p[0] = (unsigned short)Tb[0]; p[64] = (unsigned short)Tb[1]; p[128] = (unsigned short)Tb[2]; p[192] = (unsigned short)Tb[3];
            return Tb; };
        const s16x4_t D0b = ldB_D(0), D1b = ldB_D(1), D2b = ldB_D(2);
        const s16x4_t T10 = fin(1, 0, mm(ldA_m(1, 0), D0b, Z));
        const s16x4_t T21 = fin(2, 1, mm(ldA_m(2, 1), D1b, Z));
        (void)fin(3, 2, mm(ldA_m(3, 2), D2b, Z));
        const s16x4_t T20 = fin(2, 0, mm(ldA_m(2, 1), T10, mm(ldA_m(2, 0), D0b, Z)));
        (void)fin(3, 1, mm(ldA_m(3, 2), T21, mm(ldA_m(3, 1), D1b, Z)));
        (void)fin(3, 0, mm(ldA_m(3, 2), T20, mm(ldA_m(3, 1), T10, mm(ldA_m(3, 0), D0b, Z))));
    }
    { bf16* gt = (bf16*)(scratch + (size_t)n * 4096) + lane * 64;
#pragma unroll
      for (int cc = 0; cc < 8; ++cc) *(GAS v4u*)(gt + 8 * cc) = *(const LAS v4u*)(TT + lane * 64 + 8 * cc); }
    __syncthreads();
}

constexpr int P_QI = 0, P_KI = 16384, P_QS = 32768, P_KG = 49152, P_TT = 57344, P_KT = 65536, P_VR = P_KT + 2 * 64 * GT_TR, P_VT = P_VR + 64 * GT_TR, P_ST = P_VT + 64 * GT_TR,
              P_OB = P_ST + 2 * 64 * GT_TR, P_VEC = P_OB + 16384, P_END = P_VEC + 768;
static_assert(P_END <= RING_BYTES && P_OB % 16 == 0 && P_VEC % 16 == 0, "GDN pipelined LDS map");
struct GdnCell { v4u rq, rk, rv, tt; f32x2 gb; float gl; };
__device__ __forceinline__ void gdn_load_cell(GdnCell& C, const bf16* xbp, const float* scratch, int b, int h, int n, int t, int c) {
    const bf16* base = xbp + ((size_t)b * SEQ + n * CHUNK + t) * DM + h * 64 + 8 * c;
    const bf16* gbase = xbp + ((size_t)b * SEQ + n * CHUNK + t) * DM + XB_GB + 4 * h;
    C.rq = *(const GAS v4u*)(base + XB_Q); C.rk = *(const GAS v4u*)(base + XB_K); C.rv = *(const GAS v4u*)(base + XB_V);
    C.gb = *(const GAS f32x2*)gbase; C.gl = (*(const GAS f32x2*)(gbase + (size_t)(63 - t) * DM)).x;
    C.tt = *(const GAS v4u*)((const bf16*)(scratch + (size_t)n * 4096) + t * 64 + 8 * c);
}
__device__ __forceinline__ void gdn_stage_cell(LAS unsigned char* L, int buf, const GdnCell& C, int t, int c) {
    float q[8], k[8], v[8]; up8bf(C.rq, q); up8bf(C.rk, k); up8bf(C.rv, v);
    const float eg = fexp(C.gb.x), ek = fexp(C.gl - C.gb.x);
    float qs_[8], kg_[8], kt_[8];
#pragma unroll
    for (int e = 0; e < 8; ++e) { qs_[e] = q[e] * eg; kg_[e] = k[e] * eg; kt_[e] = k[e] * ek; }
    const int sw = (c ^ ((t >> 1) & 7)) << 4;
    *(LAS v4u*)(L + P_QI + buf * 8192 + t * 128 + sw) = C.rq; *(LAS v4u*)(L + P_KI + buf * 8192 + t * 128 + sw) = C.rk;
    st_rm(L + P_QS + buf * 8192, t, c, qs_); st_rm(L + P_KG, t, c, kg_); st_trT(L + P_KT + buf * 64 * GT_TR, t, c, kt_); st_trT(L + P_VR, t, c, v);
    *(LAS v4u*)(L + P_TT + t * 128 + sw) = C.tt;
    if (c == 0) { LAS float* vec = (LAS float*)(L + P_VEC); vec[t] = C.gb.y; vec[64 + buf * 64 + t] = C.gb.x; }
}
__device__ __forceinline__ void gdn_main(Frame& F, const MixCtx& X, int b, int h) {
    OPAQUE_TID();
    LAS unsigned char* L = F.lds + RING_OFF;
    LAS float* bet = (LAS float*)(L + P_VEC); LAS float* obuf = (LAS float*)(L + P_OB);
    const int ql = lane & 31, hh = lane >> 5;
    const TrLane TL = tr_lane(ql, hh);
    const float* ng = X.a->in[I_GDN] + X.l * 256 + h * 64;
    const float* scratch = (const float*)(X.a->ws + WS_GDN) + (size_t)(b * 4 + h) * (NCHUNK * 4096);
    const bf16* xbp = (const bf16*)X.a->out;
    if (tid == 0) {
        gu32* cnt = F.ctl + CW_GDN + 64 * (64 * X.l + 4 * b + h) + (X.yb == X.proj ? 0 : 32); unsigned sp = 0;
        while (__hip_atomic_load(cnt, RLX_AGENT) < 4u) { __builtin_amdgcn_s_sleep(2); if (++sp > (1u << 22)) { __hip_atomic_store(F.ctl + CW_TMO, 1u, RLX_AGENT); break; } }
        __builtin_amdgcn_fence(__ATOMIC_ACQUIRE, "agent"); asm volatile("s_waitcnt vmcnt(0)" ::: "memory"); }
    __syncthreads();
    for (int i = tid; i < 2 * 64 * GT_TR / 4; i += NTHR) ((LAS unsigned*)(L + P_ST))[i] = 0u;
    const int sid = tid & 255, t0 = sid >> 3, c = sid & 7;
    const bool stager = wave >= 4;
    GdnCell C0, C1; v4u g0 = {0u, 0u, 0u, 0u}, g1 = {0u, 0u, 0u, 0u};
    if (stager) {
        gdn_load_cell(C0, xbp, scratch, b, h, 0, t0, c); gdn_load_cell(C1, xbp, scratch, b, h, 0, t0 + 32, c);
        gdn_stage_cell(L, 0, C0, t0, c); gdn_stage_cell(L, 0, C1, t0 + 32, c);
        gdn_load_cell(C0, xbp, scratch, b, h, 1, t0, c); gdn_load_cell(C1, xbp, scratch, b, h, 1, t0 + 32, c);
    }
    f32x16 SA, SB;
#pragma unroll
    for (int i = 0; i < 16; ++i) { SA[i] = 0.f; SB[i] = 0.f; }
    __syncthreads();
    for (int n = 0; n < NCHUNK; ++n) {
        const int cur = n & 1, prv = cur ^ 1;
        if (wave < 4) {
            const int tb = wave & 1, vb = wave >> 1;
            f32x16 R0, R1;
#pragma unroll
            for (int tb2 = 0; tb2 < 2; ++tb2) {
                f32x16 ks;
#pragma unroll
                for (int i = 0; i < 16; ++i) ks[i] = 0.f;
#pragma unroll
                for (int s = 0; s < 4; ++s) ks = __builtin_amdgcn_mfma_f32_32x32x16_bf16(frag_rm(L + P_KG, 32 * tb2 + ql, s, hh), frag_tr_x(L + P_ST + prv * 64 * GT_TR, TL, 32 * vb + ql, s), ks, 0, 0, 0);
#pragma unroll
                for (int g = 0; g < 4; ++g) { const s16x4 vr = *(const LAS s16x4*)(L + P_VR + tr_c4(TL, 32 * vb + ql, tb2, g));
                    const f32x4 be = *(const LAS f32x4*)(bet + 32 * tb2 + 8 * g + 4 * hh);
#pragma unroll
                    for (int i = 0; i < 4; ++i) { const float r = be[i] * (__builtin_bit_cast(float, (unsigned)(unsigned short)vr[i] << 16) - ks[4 * g + i]); if (tb2 == 0) R0[4 * g + i] = r; else R1[4 * g + i] = r; } }
            }
            f32x16 vn;
#pragma unroll
            for (int i = 0; i < 16; ++i) vn[i] = 0.f;
#pragma unroll
            for (int sp = 0; sp < 2; ++sp) {
                vn = __builtin_amdgcn_mfma_f32_32x32x16_bf16(frag_rm_perm(L + P_TT, 32 * tb + ql, 16 * sp, hh), pack8(R0[8 * sp], R0[8 * sp + 1], R0[8 * sp + 2], R0[8 * sp + 3], R0[8 * sp + 4], R0[8 * sp + 5], R0[8 * sp + 6], R0[8 * sp + 7]), vn, 0, 0, 0);
                vn = __builtin_amdgcn_mfma_f32_32x32x16_bf16(frag_rm_perm(L + P_TT, 32 * tb + ql, 32 + 16 * sp, hh), pack8(R1[8 * sp], R1[8 * sp + 1], R1[8 * sp + 2], R1[8 * sp + 3], R1[8 * sp + 4], R1[8 * sp + 5], R1[8 * sp + 6], R1[8 * sp + 7]), vn, 0, 0, 0); }
#pragma unroll
            for (int g = 0; g < 4; ++g) *(LAS unsigned long long*)(L + P_VT + tr_c4(TL, 32 * vb + ql, tb, g)) = pack4(vn[4 * g], vn[4 * g + 1], vn[4 * g + 2], vn[4 * g + 3]);
        } else if (n > 0) {
            const size_t rowp = (size_t)b * SEQ + (n - 1) * CHUNK;
            scan_epilogue<1>(obuf, g0, X.yb, X.ldy, rowp + t0, Y_B + h * 64, ng, t0, c);
            scan_epilogue<1>(obuf, g1, X.yb, X.ldy, rowp + t0 + 32, Y_B + h * 64, ng, t0 + 32, c);
        }
        LDS_BARRIER();
        if (wave < 2) {
            const int tb = wave;
            const LAS float* gcs = (const LAS float*)(L + P_VEC) + 64 + cur * 64;
            f32x16 O0, O1;
#pragma unroll
            for (int i = 0; i < 16; ++i) { O0[i] = 0.f; O1[i] = 0.f; }
            const float gctq = gcs[32 * tb + ql];
#pragma unroll
            for (int sb = 0; sb < 2; ++sb) {
                if (sb <= tb) {
                    f32x16 P;
#pragma unroll
                    for (int i = 0; i < 16; ++i) P[i] = 0.f;
#pragma unroll
                    for (int s = 0; s < 4; ++s) P = __builtin_amdgcn_mfma_f32_32x32x16_bf16(frag_rm(L + P_KI + cur * 8192, 32 * sb + ql, s, hh), frag_rm(L + P_QI + cur * 8192, 32 * tb + ql, s, hh), P, 0, 0, 0);
                    float w[16];
#pragma unroll
                    for (int g = 0; g < 4; ++g) { const f32x4 gs = *(const LAS f32x4*)(gcs + 32 * sb + 8 * g + 4 * hh);
#pragma unroll
                        for (int i = 0; i < 4; ++i) { const int sidx = 32 * sb + 8 * g + 4 * hh + i; w[4 * g + i] = (sidx <= 32 * tb + ql) ? P[4 * g + i] * fexp(gctq - gs[i]) : 0.f; } }
#pragma unroll
                    for (int sp = 0; sp < 2; ++sp) { const bf16x8 pf = pack8(w[8 * sp], w[8 * sp + 1], w[8 * sp + 2], w[8 * sp + 3], w[8 * sp + 4], w[8 * sp + 5], w[8 * sp + 6], w[8 * sp + 7]);
                        O0 = __builtin_amdgcn_mfma_f32_32x32x16_bf16(frag_tr_perm_x(L + P_VT, TL, ql, 32 * sb + 16 * sp), pf, O0, 0, 0, 0);
                        O1 = __builtin_amdgcn_mfma_f32_32x32x16_bf16(frag_tr_perm_x(L + P_VT, TL, 32 + ql, 32 * sb + 16 * sp), pf, O1, 0, 0, 0); }
                }
            }
#pragma unroll
            for (int s = 0; s < 4; ++s) { const bf16x8 qf = frag_rm(L + P_QS + cur * 8192, 32 * tb + ql, s, hh);
                O0 = __builtin_amdgcn_mfma_f32_32x32x16_bf16(frag_tr_x(L + P_ST + prv * 64 * GT_TR, TL, ql, s), qf, O0, 0, 0, 0);
                O1 = __builtin_amdgcn_mfma_f32_32x32x16_bf16(frag_tr_x(L + P_ST + prv * 64 * GT_TR, TL, 32 + ql, s), qf, O1, 0, 0, 0); }
#pragma unroll
            for (int g = 0; g < 4; ++g) { LAS float* op = obuf + (32 * tb + ql) * 64 + 8 * g + 4 * hh;
                *(LAS f32x4*)op = (f32x4){O0[4 * g], O0[4 * g + 1], O0[4 * g + 2], O0[4 * g + 3]}; *(LAS f32x4*)(op + 32) = (f32x4){O1[4 * g], O1[4 * g + 1], O1[4 * g + 2], O1[4 * g + 3]}; }
        } else if (wave < 4) {
            const int kb = wave & 1; const float el = fexp(((const LAS float*)(L + P_VEC))[64 + cur * 64 + 63]);
            const LAS unsigned char* KT = L + P_KT + cur * 64 * GT_TR;
#pragma unroll
            for (int i = 0; i < 16; ++i) { SA[i] *= el; SB[i] *= el; }
#pragma unroll
            for (int s = 0; s < 4; ++s) { const bf16x8 kf = frag_tr_x(KT, TL, 32 * kb + ql, s);
                SA = __builtin_amdgcn_mfma_f32_32x32x16_bf16(kf, frag_tr_x(L + P_VT, TL, ql, s), SA, 0, 0, 0);
                SB = __builtin_amdgcn_mfma_f32_32x32x16_bf16(kf, frag_tr_x(L + P_VT, TL, 32 + ql, s), SB, 0, 0, 0); }
            LAS unsigned char* ST = L + P_ST + cur * 64 * GT_TR;
#pragma unroll
            for (int g = 0; g < 4; ++g) { *(LAS unsigned long long*)(ST + tr_c4(TL, ql, kb, g)) = pack4(SA[4 * g], SA[4 * g + 1], SA[4 * g + 2], SA[4 * g + 3]);
                *(LAS unsigned long long*)(ST + tr_c4(TL, 32 + ql, kb, g)) = pack4(SB[4 * g], SB[4 * g + 1], SB[4 * g + 2], SB[4 * g + 3]); }
        } else {
            const bf16* gt = X.proj + ((size_t)b * SEQ + n * CHUNK + t0) * NMIX + C_BG + h * 64 + 8 * c;
            g0 = *(const GAS v4u*)gt; g1 = *(const GAS v4u*)(gt + (size_t)32 * NMIX);
            if (n + 1 < NCHUNK) { gdn_stage_cell(L, prv, C0, t0, c); gdn_stage_cell(L, prv, C1, t0 + 32, c);
                if (n + 2 < NCHUNK) { gdn_load_cell(C0, xbp, scratch, b, h, n + 2, t0, c); gdn_load_cell(C1, xbp, scratch, b, h, n + 2, t0 + 32, c); } }
        }
        LDS_BARRIER();
    }
    if (wave >= 4) {
        const size_t rowp = (size_t)b * SEQ + (NCHUNK - 1) * CHUNK;
        scan_epilogue<1>(obuf, g0, X.yb, X.ldy, rowp + t0, Y_B + h * 64, ng, t0, c);
        scan_epilogue<1>(obuf, g1, X.yb, X.ldy, rowp + t0 + 32, Y_B + h * 64, ng, t0 + 32, c);
    }
    __syncthreads();
}
__device__ __forceinline__ void gdn_prep_unit(Frame& F, const MixCtx& X, int b, int h, int part) {
    gdn_prep(F, X, b, h, part);
    gdn_tpass(F, X, b, h, part);
    asm volatile("s_waitcnt vmcnt(0)" ::: "memory");
    __syncthreads();
    if (threadIdx.x == 0) { __builtin_amdgcn_fence(__ATOMIC_RELEASE, "agent"); asm volatile("s_waitcnt vmcnt(0)" ::: "memory");
        __hip_atomic_fetch_add(F.ctl + CW_GDN + 64 * (64 * X.l + 4 * b + h), 1u, RLX_AGENT); }
}

constexpr int HO_QI = 0, HO_KI = 8192, HO_QS = 16384, HO_KT = 24576, HO_VT = HO_KT + 64 * GT_TR, HO_ST = HO_VT + 64 * GT_TR, HO_LF = HO_ST + 64 * GT_TR, HO_OB = HO_LF + 16384, HO_SEG = HO_OB + 16384, HO_DD = HO_SEG + 2048, HO_END = HO_DD + 256;
static_assert(HO_END <= RING_BYTES && HO_LF % 16 == 0, "HGRN2 LDS map");
__device__ __forceinline__ void hgrn_unit(Frame& F, const MixCtx& X, int b, int h) {
    OPAQUE_TID();
    LAS unsigned char* L = F.lds + RING_OFF;
    LAS float* LF = (LAS float*)(L + HO_LF); LAS float* obuf = (LAS float*)(L + HO_OB); LAS float* seg = (LAS float*)(L + HO_SEG); LAS float* dd = (LAS float*)(L + HO_DD);
    const int t = tid >> 3, c = tid & 7, ql = lane & 31, hh = lane >> 5;
    const TrLane TL = tr_lane(ql, hh);
    float lb[8];
    { const float* lg = X.a->in[I_LB];
#pragma unroll
      for (int e = 0; e < 8; ++e) { const int ch = h * 64 + 8 * c + e; const float x0 = lg[ch], x1 = lg[256 + ch], x2 = lg[512 + ch], x3 = lg[768 + ch];
          const float mx = fmaxf(fmaxf(x0, x1), fmaxf(x2, x3)); const float e0 = fexp(x0 - mx), e1 = fexp(x1 - mx), e2 = fexp(x2 - mx), e3 = fexp(x3 - mx);
          const float inv = 1.f / (e0 + e1 + e2 + e3); const float c1 = e1 * inv, c2 = c1 + e2 * inv, c3 = c2 + e3 * inv;
          lb[e] = X.l == 0 ? 0.f : X.l == 1 ? c1 : X.l == 2 ? c2 : c3; } }
    const float* ng = X.a->in[I_HGN] + X.l * 256 + h * 64;
    for (int i = tid; i < 64 * GT_TR / 4; i += NTHR) ((LAS unsigned*)(L + HO_ST))[i] = 0u;
    f32x16 Sacc;
#pragma unroll
    for (int i = 0; i < 16; ++i) Sacc[i] = 0.f;
    const bf16* base = X.proj + ((size_t)b * SEQ + t) * NMIX + h * 64 + 8 * c;
    v4u rq = *(const GAS v4u*)(base + C_AQ), rf = *(const GAS v4u*)(base + C_AF), ri = *(const GAS v4u*)(base + C_AI), rg = *(const GAS v4u*)(base + C_AG);
    __syncthreads();
    for (int n = 0; n < NCHUNK; ++n) {
        const size_t row = (size_t)b * SEQ + n * CHUNK + t;
        float q[8], kk[8], iv[8], lf[8];
        { float f[8]; up8bf(rq, q); up8bf(rf, f); up8bf(ri, iv);
#pragma unroll
          for (int e = 0; e < 8; ++e) { q[e] = fsilu(q[e]); const float fe = lb[e] + (1.f - lb[e]) * fsigmoid(f[e]); kk[e] = 1.f - fe; lf[e] = __builtin_amdgcn_logf(fe) * 0.6931471805599453f; iv[e] = fsilu(iv[e]); } }
        st8f(LF + t * 64 + 8 * c, lf);
        const v4u gcur = rg;
        LDS_BARRIER();
        if (n + 1 < NCHUNK) { const bf16* nb = base + (size_t)(n + 1) * CHUNK * NMIX;
            rq = *(const GAS v4u*)(nb + C_AQ); rf = *(const GAS v4u*)(nb + C_AF); ri = *(const GAS v4u*)(nb + C_AI); rg = *(const GAS v4u*)(nb + C_AG); }
        { const int k = tid & 63, sg = tid >> 6; float x = 0.f;
#pragma unroll
          for (int j = 0; j < 8; ++j) { x += LF[(8 * sg + j) * 64 + k]; LF[(8 * sg + j) * 64 + k] = x; }
          seg[sg * 64 + k] = x; }
        LDS_BARRIER();
        { float bt[8], r31[8], bl[8];
          { float run[8], mine[8], p31[8];
#pragma unroll
            for (int e = 0; e < 8; ++e) { run[e] = 0.f; mine[e] = 0.f; p31[e] = 0.f; }
#pragma unroll
            for (int sg = 0; sg < 8; ++sg) { float sv[8]; ld8f(seg + sg * 64 + 8 * c, sv);
#pragma unroll
                for (int e = 0; e < 8; ++e) { if (sg == (t >> 3)) mine[e] = run[e]; if (sg == 3) p31[e] = run[e]; run[e] += sv[e]; } }
            float l31[8], lt[8]; ld8f(LF + 31 * 64 + 8 * c, l31); ld8f(LF + t * 64 + 8 * c, lt);
#pragma unroll
            for (int e = 0; e < 8; ++e) { bt[e] = lt[e] + mine[e]; r31[e] = l31[e] + p31[e]; bl[e] = run[e]; } }
          float qi[8], ki[8], qs[8], kt[8];
#pragma unroll
          for (int e = 0; e < 8; ++e) { qi[e] = q[e] * fexp(bt[e] - r31[e]); ki[e] = kk[e] * fexp(r31[e] - bt[e]); qs[e] = q[e] * fexp(bt[e]); kt[e] = kk[e] * fexp(bl[e] - bt[e]); }
          st_rm(L + HO_QI, t, c, qi); st_rm(L + HO_KI, t, c, ki); st_rm(L + HO_QS, t, c, qs); st_trT(L + HO_KT, t, c, kt); st_trT(L + HO_VT, t, c, iv);
          if (t == 0) { float de[8];
#pragma unroll
              for (int e = 0; e < 8; ++e) de[e] = fexp(bl[e]);
              st8f(dd + 8 * c, de); } }
        LDS_BARRIER();
        if (wave < 2) {
            const int tb = wave;
            f32x16 O0, O1;
#pragma unroll
            for (int i = 0; i < 16; ++i) { O0[i] = 0.f; O1[i] = 0.f; }
#pragma unroll
            for (int sb = 0; sb < 2; ++sb) {
                if (sb <= tb) {
                    f32x16 P;
#pragma unroll
                    for (int i = 0; i < 16; ++i) P[i] = 0.f;
#pragma unroll
                    for (int s = 0; s < 4; ++s) P = __builtin_amdgcn_mfma_f32_32x32x16_bf16(frag_rm(L + HO_KI, 32 * sb + ql, s, hh), frag_rm(L + HO_QI, 32 * tb + ql, s, hh), P, 0, 0, 0);
                    float w[16];
#pragma unroll
                    for (int i = 0; i < 16; ++i) { const int sidx = 32 * sb + (i & 3) + 8 * (i >> 2) + 4 * hh; w[i] = (sidx <= 32 * tb + ql) ? P[i] : 0.f; }
#pragma unroll
                    for (int sp = 0; sp < 2; ++sp) { const bf16x8 pf = pack8(w[8 * sp], w[8 * sp + 1], w[8 * sp + 2], w[8 * sp + 3], w[8 * sp + 4], w[8 * sp + 5], w[8 * sp + 6], w[8 * sp + 7]);
                        O0 = __builtin_amdgcn_mfma_f32_32x32x16_bf16(frag_tr_perm_x(L + HO_VT, TL, ql, 32 * sb + 16 * sp), pf, O0, 0, 0, 0);
                        O1 = __builtin_amdgcn_mfma_f32_32x32x16_bf16(frag_tr_perm_x(L + HO_VT, TL, 32 + ql, 32 * sb + 16 * sp), pf, O1, 0, 0, 0); }
                }
            }
#pragma unroll
            for (int s = 0; s < 4; ++s) { const bf16x8 qf = frag_rm(L + HO_QS, 32 * tb + ql, s, hh);
                O0 = __builtin_amdgcn_mfma_f32_32x32x16_bf16(frag_tr_x(L + HO_ST, TL, ql, s), qf, O0, 0, 0, 0);
                O1 = __builtin_amdgcn_mfma_f32_32x32x16_bf16(frag_tr_x(L + HO_ST, TL, 32 + ql, s), qf, O1, 0, 0, 0); }
#pragma unroll
            for (int g = 0; g < 4; ++g) { LAS float* op = obuf + (32 * tb + ql) * 64 + 8 * g + 4 * hh;
                *(LAS f32x4*)op = (f32x4){O0[4 * g], O0[4 * g + 1], O0[4 * g + 2], O0[4 * g + 3]}; *(LAS f32x4*)(op + 32) = (f32x4){O1[4 * g], O1[4 * g + 1], O1[4 * g + 2], O1[4 * g + 3]}; }
        } else if (wave >= 4) {
            const int kb = wave & 1, vb = (wave >> 1) & 1;
#pragma unroll
            for (int g = 0; g < 4; ++g) { const f32x4 de = *(const LAS f32x4*)(dd + 32 * kb + 8 * g + 4 * hh);
                Sacc[4 * g] *= de.x; Sacc[4 * g + 1] *= de.y; Sacc[4 * g + 2] *= de.z; Sacc[4 * g + 3] *= de.w; }
#pragma unroll
            for (int s = 0; s < 4; ++s) Sacc = __builtin_amdgcn_mfma_f32_32x32x16_bf16(frag_tr_x(L + HO_KT, TL, 32 * kb + ql, s), frag_tr_x(L + HO_VT, TL, 32 * vb + ql, s), Sacc, 0, 0, 0);
        }
        LDS_BARRIER();
        scan_epilogue<0>(obuf, gcur, X.yb, X.ldy, row, Y_A + h * 64, ng, t, c);
        if (wave >= 4) { const int kb = wave & 1, vb = (wave >> 1) & 1;
#pragma unroll
            for (int g = 0; g < 4; ++g) *(LAS unsigned long long*)(L + HO_ST + tr_c4(TL, 32 * vb + ql, kb, g)) = pack4(Sacc[4 * g], Sacc[4 * g + 1], Sacc[4 * g + 2], Sacc[4 * g + 3]);
        }
    }
    __syncthreads();
}

__device__ __forceinline__ void ret_unit(Frame& F, const MixCtx& X, int b, int h) {
    OPAQUE_TID();
    LAS unsigned char* L = F.lds + RING_OFF;
    LAS float* obuf = (LAS float*)(L + HO_OB);
    const int t = tid >> 3, c = tid & 7, ql = lane & 31, hh = lane >> 5;
    const TrLane TL = tr_lane(ql, hh);
    const float lg2 = __builtin_amdgcn_logf(1.f - __builtin_amdgcn_exp2f(-5.f - (float)h));
    const float* ng = X.a->in[I_RETN] + X.l * 256 + h * 64;
    const f32x2* rope = (const f32x2*)(X.a->ws + WS_ROPE);
    for (int i = tid; i < 64 * GT_TR / 4; i += NTHR) ((LAS unsigned*)(L + HO_ST))[i] = 0u;
    for (int i = tid; i < 3 * 8192 / 4; i += NTHR) ((LAS unsigned*)(L + HO_QI))[i] = 0u;
    f32x16 Sacc;
#pragma unroll
    for (int i = 0; i < 16; ++i) Sacc[i] = 0.f;
    float dmask[16], dfull[16];
#pragma unroll
    for (int i = 0; i < 16; ++i) { const int kap = (i & 3) + 8 * (i >> 2) + 4 * hh; dmask[i] = kap <= ql ? __builtin_amdgcn_exp2f((float)(ql - kap) * lg2) : 0.f; dfull[i] = __builtin_amdgcn_exp2f((float)(32 + ql - kap) * lg2); }
    const float g64 = __builtin_amdgcn_exp2f(64.f * lg2), gq = __builtin_amdgcn_exp2f((float)(t + 1) * lg2), gk = __builtin_amdgcn_exp2f((float)(63 - t) * lg2);
    const bf16* base = X.proj + ((size_t)b * SEQ + t) * NMIX + h * 64 + 8 * c;
    const int i0 = 8 * (c & 1); const bool hi = (c & 2) != 0; const float sc = c >= 4 ? 0.17677669529663687f : 1.f;
    v4u rx = *(const GAS v4u*)(base + C_DQK), rv = *(const GAS v4u*)(base + C_DV), rg = *(const GAS v4u*)(base + C_DG);
    f32x2 cs[8];
#pragma unroll
    for (int e = 0; e < 8; ++e) cs[e] = rope[t * 16 + i0 + e];
    __syncthreads();
    for (int n = 0; n < NCHUNK; ++n) {
        const size_t row = (size_t)b * SEQ + n * CHUNK + t;
        {
          float x[8], p[8]; up8bf(rx, x);
#pragma unroll
          for (int e = 0; e < 8; ++e) p[e] = __shfl_xor(x[e], 2);
          float o[8], od[8];
#pragma unroll
          for (int e = 0; e < 8; ++e) { o[e] = (hi ? (p[e] * cs[e].y + x[e] * cs[e].x) : (x[e] * cs[e].x - p[e] * cs[e].y)) * sc; od[e] = o[e] * (c < 4 ? gq : gk); }
          if (c < 4) { st_rm(L + HO_QI, t, c, o); st_rm(L + HO_QS, t, c, od); }
          else { st_rm(L + HO_KI, t, c - 4, o); st_trT(L + HO_KT, t, c - 4, od); }
          float vv[8]; up8bf(rv, vv); st_trT(L + HO_VT, t, c, vv); }
        const v4u gcur = rg;
        if (n + 1 < NCHUNK) { const bf16* nb = base + (size_t)(n + 1) * CHUNK * NMIX; rx = *(const GAS v4u*)(nb + C_DQK); rv = *(const GAS v4u*)(nb + C_DV); rg = *(const GAS v4u*)(nb + C_DG);
#pragma unroll
            for (int e = 0; e < 8; ++e) cs[e] = rope[((n + 1) * CHUNK + t) * 16 + i0 + e]; }
        LDS_BARRIER();
        if (wave < 2) {
            const int tb = wave;
            f32x16 O0, O1;
#pragma unroll
            for (int i = 0; i < 16; ++i) { O0[i] = 0.f; O1[i] = 0.f; }
#pragma unroll
            for (int sb = 0; sb < 2; ++sb) {
                if (sb <= tb) {
                    f32x16 P;
#pragma unroll
                    for (int i = 0; i < 16; ++i) P[i] = 0.f;
#pragma unroll
                    for (int s = 0; s < 2; ++s) P = __builtin_amdgcn_mfma_f32_32x32x16_bf16(frag_rm(L + HO_KI, 32 * sb + ql, s, hh), frag_rm(L + HO_QI, 32 * tb + ql, s, hh), P, 0, 0, 0);
                    float w[16];
#pragma unroll
                    for (int i = 0; i < 16; ++i) w[i] = P[i] * (sb == tb ? dmask[i] : dfull[i]);
#pragma unroll
                    for (int sp = 0; sp < 2; ++sp) { const bf16x8 pf = pack8(w[8 * sp], w[8 * sp + 1], w[8 * sp + 2], w[8 * sp + 3], w[8 * sp + 4], w[8 * sp + 5], w[8 * sp + 6], w[8 * sp + 7]);
                        O0 = __builtin_amdgcn_mfma_f32_32x32x16_bf16(frag_tr_perm_x(L + HO_VT, TL, ql, 32 * sb + 16 * sp), pf, O0, 0, 0, 0);
                        O1 = __builtin_amdgcn_mfma_f32_32x32x16_bf16(frag_tr_perm_x(L + HO_VT, TL, 32 + ql, 32 * sb + 16 * sp), pf, O1, 0, 0, 0); }
                }
            }
#pragma unroll
            for (int s = 0; s < 2; ++s) { const bf16x8 qf = frag_rm(L + HO_QS, 32 * tb + ql, s, hh);
                O0 = __builtin_amdgcn_mfma_f32_32x32x16_bf16(frag_tr_x(L + HO_ST, TL, ql, s), qf, O0, 0, 0, 0);
                O1 = __builtin_amdgcn_mfma_f32_32x32x16_bf16(frag_tr_x(L + HO_ST, TL, 32 + ql, s), qf, O1, 0, 0, 0); }
#pragma unroll
            for (int g = 0; g < 4; ++g) { LAS float* op = obuf + (32 * tb + ql) * 64 + 8 * g + 4 * hh;
                *(LAS f32x4*)op = (f32x4){O0[4 * g], O0[4 * g + 1], O0[4 * g + 2], O0[4 * g + 3]}; *(LAS f32x4*)(op + 32) = (f32x4){O1[4 * g], O1[4 * g + 1], O1[4 * g + 2], O1[4 * g + 3]}; }
        } else if (wave == 4 || wave == 5) {
            const int vb = wave & 1;
#pragma unroll
            for (int i = 0; i < 16; ++i) Sacc[i] *= g64;
#pragma unroll
            for (int s = 0; s < 4; ++s) Sacc = __builtin_amdgcn_mfma_f32_32x32x16_bf16(frag_tr_x(L + HO_KT, TL, ql, s), frag_tr_x(L + HO_VT, TL, 32 * vb + ql, s), Sacc, 0, 0, 0);
        }
        LDS_BARRIER();
        scan_epilogue<1>(obuf, gcur, X.yb, X.ldy, row, Y_D + h * 64, ng, t, c);
        if (wave == 4 || wave == 5) { const int vb = wave & 1;
#pragma unroll
            for (int g = 0; g < 4; ++g) *(LAS unsigned long long*)(L + HO_ST + tr_c4(TL, 32 * vb + ql, 0, g)) = pack4(Sacc[4 * g], Sacc[4 * g + 1], Sacc[4 * g + 2], Sacc[4 * g + 3]);
        }
    }
    __syncthreads();
}

constexpr int GDN_PREP_UNITS = 256;
constexpr int MIX_UNITS = 704 + GDN_PREP_UNITS;
#ifndef DRY_LO
#define DRY_LO 0
#define DRY_HI 64
#endif
#ifndef DRY_EXP
#define DRY_EXP 0
#endif
__device__ __forceinline__ void mixers_phase(Frame& F, const MixCtx& X0) {
    OPAQUE_TID();
    gu32* head = F.ctl + CW_QUEUE + 64 * X0.l + (X0.yb == X0.proj ? 0 : 32);
    constexpr int NDRY = DRY_EXP == 1 ? 512 : DRY_EXP == 2 ? 192 : 0;
    for (;;) {
        __syncthreads();
        if (tid == 0) F.MISC[16] = __hip_atomic_fetch_add(head, 1u, RLX_AGENT);
        __syncthreads();
        int u = __builtin_amdgcn_readfirstlane((int)F.MISC[16]);
        if (u >= MIX_UNITS + NDRY + (X0.l + 1 < DEPTH ? CONV_UNITS : 0)) break;
        if (u >= MIX_UNITS + NDRY) { convert_unit(F, *X0.a, X0.l + 1, u - MIX_UNITS - NDRY); continue; }
        MixCtx X = X0;
        if (DRY_EXP == 3 && X0.yb != X0.proj) { u += DRY_LO; if (u >= DRY_HI) break; }
        if (DRY_EXP == 1) { if (u >= 192 && u < 192 + 512) { X.yb = (bf16*)X0.a->out + (size_t)M * DM; X.ldy = DM; } else if (u >= 192 + 512) u -= 512; }
        if (DRY_EXP == 2) { if (u < 192) { X.yb = (bf16*)X0.a->out + (size_t)M * DM; X.ldy = DM; } else u -= 192; }
        if (u < GDN_PREP_UNITS) { gdn_prep_unit(F, X, u >> 4, (u >> 2) & 3, u & 3); continue; }
        u -= GDN_PREP_UNITS;
        if (u < 64) gdn_main(F, X, u >> 2, u & 3);
        else if (u < 128) { if (HGRN_CHUNKED) hgrn_unit(F, X, (u - 64) >> 2, (u - 64) & 3); else scan_hgrn2(F, X, (u - 64) >> 2, (u - 64) & 3); }
        else if (u < 192) { if (RET_CHUNKED) ret_unit(F, X, (u - 128) >> 2, (u - 128) & 3); else scan_retention(F, X, (u - 128) >> 2, (u - 128) & 3); }
        else { const int a = u - 192, bh = a & 63; sb_unit(F, X, bh >> 2, bh & 3, 7 - (a >> 6)); }
    }
}

__device__ __forceinline__ void final_norm(Frame& F, float* x, const float* g) {
    OPAQUE_TID();
    const int gw = F.vcu * NWAVES + wave, NGW = F.G * NWAVES;
    f32x4 gv[4];
#pragma unroll
    for (int j = 0; j < 4; ++j) gv[j] = ((const f32x4*)g)[lane + 64 * j];
    for (int m = gw; m < M; m += NGW) {
        GAS f32x4* xr = (GAS f32x4*)(x + (size_t)m * DM) + lane;
        f32x4 v[4]; float s = 0.f;
#pragma unroll
        for (int j = 0; j < 4; ++j) { v[j] = xr[64 * j]; s += (v[j].x * v[j].x + v[j].y * v[j].y) + (v[j].z * v[j].z + v[j].w * v[j].w); }
        s = wave_sum(s);
        const float rstd = 1.f / sqrtf(s * (1.f / DM) + EPS);
#pragma unroll
        for (int j = 0; j < 4; ++j) xr[64 * j] = v[j] * rstd * gv[j];
    }
}

constexpr int PH_PRO = 0, PH_PER_J = 6, PH_FINAL = 1 + 8 * PH_PER_J, NPH = PH_FINAL + 1;
__global__ void __launch_bounds__(NTHR, 2) fwd_kernel(Args args) {
    extern __shared__ __attribute__((aligned(16))) unsigned char lds[];
    Frame F;
    F.lds = (LAS unsigned char*)lds;
    F.MISC = (volatile LAS unsigned*)(F.lds + MISC_OFF);
    F.G = gridDim.x; { const int bx = blockIdx.x; F.vcu = (F.G % 8 == 0) ? (bx % 8) * (F.G / 8) + bx / 8 : bx; }
    unsigned char* ws = args.ws;
    F.ctl = (gu32*)(ws + WS_CTL);
    for (int u = threadIdx.x; u < (LDS_BYTES - LDSCTL_OFF) / 4; u += NTHR) ((LAS unsigned*)(F.lds + LDSCTL_OFF))[u] = 0u;
    __syncthreads();
    const int lo = args.ph_lo, hi = args.ph_hi;
    const bool multi = (hi - lo) > 1;
    XcdBarrier bar; bar.bar = (unsigned*)(F.ctl + CW_BAR); bar.x = 0; bar.st = nullptr;
    if (multi) bar = xcd_barrier_post((unsigned*)(F.ctl + CW_BAR), F.MISC + 8);
#define IN(k) (lo <= (k) && (k) < hi)
#define GRID_BAR() do { if (multi) xcd_barrier(bar); } while (0)

    bf16* xb = (bf16*)(ws + WS_XB);
    bf16* big = (bf16*)(ws + WS_BIG);
    float* ssq = (float*)(ws + WS_SSQ);

#if DIAG
    unsigned long long tacc[6] = {0, 0, 0, 0, 0, 0}; unsigned long long tst = __builtin_amdgcn_s_memrealtime();
#define DSTAMP(k) do { const unsigned long long tn = __builtin_amdgcn_s_memrealtime(); tacc[k] += tn - tst; tst = tn; } while (0)
#else
#define DSTAMP(k) do {} while (0)
#endif
    if (IN(PH_PRO)) { p0_prologue(F, args); GRID_BAR(); DSTAMP(0); }

    const bool fused_fin = multi && F.G == 256;
    for (int j = 0; j < 8; ++j) {
        const int l = j >> 1, odd = j & 1, pb = 1 + j * PH_PER_J;
        const unsigned char* wl = ws + WS_W + (size_t)l * WL_BYTES;
        if (IN(pb + 0)) {
            pg8::Gemm g{xb, (const bf16*)(wl + (odd ? WL_FI2 : WL_FI1)), M, NFI, DM, DM}; pg8::StaticOrder S; S.init(M, NFI, F.G, (int)blockIdx.x);
            pg8::EpiSwiglu E{big, DFF, ssq, 1.f / DM, (LAS float*)(F.lds + RS_OFF), -1};
            pg8::gemm_phase<pg8::EpiSwiglu, pg8::StaticOrder, true, true>(F.lds + RING_OFF, g, S, E);
            GRID_BAR(); DSTAMP(1);
        }
        if (IN(pb + 1)) {
            pg8::Gemm g{big, (const bf16*)(wl + (odd ? WL_FO2 : WL_FO1)), M, DM, DFF, DFF}; pg8::StaticOrder S; S.init(M, DM, F.G, (int)blockIdx.x);
            if (j == 7 && fused_fin) {
                pg8::EpiFinal E{args.out, xb, ssq, (unsigned*)(F.ctl + CW_FIN), args.in[I_FN], DM, 0.5f, (unsigned*)(F.ctl + CW_TMO)};
                pg8::gemm_phase<pg8::EpiFinal, pg8::StaticOrder, true, true>(F.lds + RING_OFF, g, S, E);
            } else {
                pg8::EpiResid E{j == 0 ? args.in[I_X] : nullptr, j == 7 ? args.out : nullptr, xb, ssq, DM, 0.5f, odd ? nullptr : (const bf16*)(wl + WL_MI) + (size_t)NMIX_G * DM, (float*)((unsigned char*)args.out + OUT_ABP)};
                pg8::gemm_phase<pg8::EpiResid, pg8::StaticOrder, true, true>(F.lds + RING_OFF, g, S, E);
                GRID_BAR(); DSTAMP(2);
            }
        }
        if (!odd) {
            if (IN(pb + 2)) {
                pg8::Gemm g{xb, (const bf16*)(wl + WL_MI), M, NMIX_G, DM, DM}; pg8::StaticOrder S; S.init(M, NMIX_G, F.G, (int)blockIdx.x);
                pg8::EpiProj E{big, NMIX, ssq, 1.f / DM, (LAS float*)(F.lds + RS_OFF), -1};
                pg8::gemm_phase<pg8::EpiProj, pg8::StaticOrder, true, true>(F.lds + RING_OFF, g, S, E);
                GRID_BAR(); DSTAMP(3);
            }
            if (IN(pb + 3)) {
#if DRY_EXP == 3
                { MixCtx Xd{big, l, &args, (bf16*)args.out + (size_t)M * DM, DM}; mixers_phase(F, Xd); GRID_BAR(); }
#endif
                MixCtx X{big, l, &args, big, NMIX};
                mixers_phase(F, X);
                GRID_BAR(); DSTAMP(4);
            }
            if (IN(pb + 4)) {
                pg8::Gemm g{big, (const bf16*)(wl + WL_MO), M, DM, DM, NMIX}; pg8::StaticOrder S; S.init(M, DM, F.G, (int)blockIdx.x);
                pg8::EpiResid E{nullptr, nullptr, xb, ssq, DM, 1.f, nullptr, nullptr};
                pg8::gemm_phase<pg8::EpiResid, pg8::StaticOrder, true, true>(F.lds + RING_OFF, g, S, E);
                GRID_BAR(); DSTAMP(5);
            }
        }
    }
    if (IN(PH_FINAL) && !fused_fin) final_norm(F, args.out, args.in[I_FN]);
#if DIAG
    {
        GRID_BAR();
        if (blockIdx.x == 0 && threadIdx.x == 0) { __hip_atomic_store(F.ctl + 16, (unsigned)(tacc[DIAG_A] / 100), RLX_AGENT); __hip_atomic_store(F.ctl + 17, (unsigned)(tacc[DIAG_B] / 100), RLX_AGENT); }
        GRID_BAR();
        const float va = (float)__hip_atomic_load(F.ctl + 16, RLX_AGENT), vb = (float)__hip_atomic_load(F.ctl + 17, RLX_AGENT);
        for (size_t i = (size_t)blockIdx.x * NTHR + threadIdx.x; i < (size_t)M * DM; i += (size_t)gridDim.x * NTHR) args.out[i] = (i == 0) ? vb : va;
    }
#endif
#undef IN
#undef GRID_BAR
}

#ifndef MK_PER_PHASE
#define MK_PER_PHASE 0
#endif
extern "C" void kernel_launch(void* const* d_in, const int* in_sizes, int n_in, void* d_out, int out_size, void* d_ws, size_t ws_size, hipStream_t stream) {
    static int grid = 0;
    if (grid == 0) {
        if (n_in != 19 || in_sizes[0] != M * DM || out_size != M * DM || ws_size < WS_END) {
            fprintf(stderr, "kernel_launch: built for 19 inputs, x/out of %d floats, >= %zu bytes of workspace; got n_in %d, in0 %d, out %d, ws %zu; nothing launched\n", M * DM, (size_t)WS_END, n_in, n_in > 0 ? in_sizes[0] : -1, out_size, ws_size);
            grid = -1; return; }
        int dev = 0, cus = 0, per_cu = 0;
        if (hipGetDevice(&dev) != hipSuccess || hipDeviceGetAttribute(&cus, hipDeviceAttributeMultiprocessorCount, dev) != hipSuccess) { fprintf(stderr, "kernel_launch: device query failed\n"); grid = -1; return; }
        if (hipFuncSetAttribute((const void*)fwd_kernel, hipFuncAttributeMaxDynamicSharedMemorySize, LDS_BYTES) != hipSuccess) { fprintf(stderr, "kernel_launch: hipFuncSetAttribute failed\n"); grid = -1; return; }
        if (hipOccupancyMaxActiveBlocksPerMultiprocessor(&per_cu, (const void*)fwd_kernel, NTHR, LDS_BYTES) != hipSuccess || per_cu < 1)
            fprintf(stderr, "kernel_launch: note: occupancy query reports %d workgroups per CU\n", per_cu);
        (void)hipGetLastError();
        grid = cus;
    }
    if (grid < 0) return;
    if (hipMemsetAsync((char*)d_ws + WS_CTL, 0, CTL_ZERO_BYTES, stream) != hipSuccess) { fprintf(stderr, "kernel_launch: hipMemsetAsync failed\n"); return; }
    Args a{};
    for (int i = 0; i < 19; ++i) a.in[i] = (const float*)d_in[i];
    a.out = (float*)d_out; a.ws = (unsigned char*)d_ws;
#if MK_PER_PHASE
    for (int p = 0; p < NPH; ++p) {
        if (p >= 1 && p < PH_FINAL) { const int j = (p - 1) / PH_PER_J, k = (p - 1) % PH_PER_J; if (k == 5 || ((j & 1) && k >= 2)) continue; }
        a.ph_lo = p; a.ph_hi = p + 1;
        hipLaunchKernelGGL(fwd_kernel, dim3(grid), dim3(NTHR), LDS_BYTES, stream, a);
    }
#else
    a.ph_lo = 0; a.ph_hi = NPH;
    hipLaunchKernelGGL(fwd_kernel, dim3(grid), dim3(NTHR), LDS_BYTES, stream, a);
#endif
    const hipError_t le = hipPeekAtLastError();
    if (le != hipSuccess) fprintf(stderr, "kernel_launch: launch failed: %s\n", hipGetErrorName(le));
}
```

```cpp
#include <hip/hip_runtime.h>
#include <cstdio>
#include <cstdint>

namespace pg8 {
#define PG8_LAS __attribute__((address_space(3)))
typedef unsigned short bf16_t;
typedef short bf16x8 __attribute__((ext_vector_type(8)));
typedef float f32x4 __attribute__((ext_vector_type(4)));
typedef unsigned u32x4 __attribute__((ext_vector_type(4)));
constexpr int BM = 256, BK = 64, HALF = 128, HTB = HALF * BK * 2  , STAGE_BYTES = 8 * HTB, NXCD = 8, WGM = 8;

__host__ __device__ __forceinline__ int lds_byte(int r, int c) { const int st = (r >> 4) * 2 + (c >> 5), rr = r & 15, cc = c & 31, ob = rr * 64 + cc * 2; return st * 1024 + (ob ^ (((ob >> 9) & 1) << 5)); }
__host__ __device__ __forceinline__ void stage_rc(int b, int& R, int& C) { const int st = b / 1024, sb = b % 1024, swz = sb ^ (((sb >> 9) & 1) << 5); R = (st >> 1) * 16 + swz / 64; C = (st & 1) * 32 + (swz % 64) / 2; }
__host__ __device__ __forceinline__ int perm32(int rho) { const int n = rho >> 4, i = rho & 15; return 8 * (i >> 2) + 4 * n + (i & 3); }

struct Unit { int pm, pn; };
struct Gemm { const bf16_t* A; const bf16_t* Bt; int M, N, K, lda; };

struct StaticOrder {
    int nM, nN, nwg, G, c;
    __host__ __device__ void init(int M, int N, int G_, int c_) { nM = M / BM; nN = N / BM; nwg = nM * nN; G = G_; c = c_; }
    __host__ __device__ bool next(int i, Unit& u) const {
        const long L = (long)i * G + c; if (L >= nwg) return false;
        int wgid = (int)L; { const int q = nwg / NXCD, r = nwg % NXCD, xcd = wgid % NXCD, off = wgid / NXCD; wgid = (xcd < r ? xcd * (q + 1) : r * (q + 1) + (xcd - r) * q) + off; }
        const int nig = WGM * nN, gid = wgid / nig, fm = gid * WGM, gsz = (nM - fm) < WGM ? (nM - fm) : WGM;
        u.pm = fm + ((wgid % nig) % gsz); u.pn = (wgid % nig) / gsz; return true;
    }
    __device__ __forceinline__ void a_ready(const Unit&) const {}
    __device__ __forceinline__ void done(const Unit&) const {}
};

__device__ __forceinline__ unsigned cvt_pk_bf16(float lo, float hi) { unsigned r; asm volatile("v_cvt_pk_bf16_f32 %0, %1, %2" : "=v"(r) : "v"(lo), "v"(hi)); return r; }

constexpr float RMS_EPS = 1e-6f;

__device__ __forceinline__ float row_ssq(const float* ssq, int row, int fq) {
    const f32x4 p = *(const f32x4*)(ssq + (size_t)row * 16 + 4 * fq);
    float s = (p.x + p.y) + (p.z + p.w);
    s += __shfl_xor(s, 16); s += __shfl_xor(s, 32);
    return s;
}
__device__ __forceinline__ void row_rstd8(const float* ssq, float inv_k, PG8_LAS float* rs, int& last_pm, const Unit& u, int wr, int wc, int fr, int fq, float (&rstd)[8]) {
    PG8_LAS float* mine = rs + (wr * 4 + wc) * 128;
    if (u.pm != last_pm) {
        const int row0 = u.pm * BM + wr * 64 + fr;
        f32x4 p[8];
#pragma unroll
        for (int j = 0; j < 8; ++j) p[j] = *(const f32x4*)(ssq + (size_t)(row0 + (j >> 2) * HALF + (j & 3) * 16) * 16 + 4 * fq);
#pragma unroll
        for (int j = 0; j < 8; ++j) { float s = (p[j].x + p[j].y) + (p[j].z + p[j].w); s += __shfl_xor(s, 16); s += __shfl_xor(s, 32);
            const float r = __builtin_amdgcn_rsqf(s * inv_k + RMS_EPS); rstd[j] = r; if (fq == 0) mine[(j >> 2) * 64 + (j & 3) * 16 + fr] = r; }
        last_pm = u.pm;
    } else {
#pragma unroll
        for (int j = 0; j < 8; ++j) rstd[j] = mine[(j >> 2) * 64 + (j & 3) * 16 + fr];
    }
}
struct EpiSwiglu {
    static constexpr bool PERM = true, AFTER_DRAIN = false;
    bf16_t* O; int ldc; const float* ssq; float inv_k; PG8_LAS float* rs; mutable int last_pm;
    __device__ __forceinline__ void operator()(const f32x4 (&acc)[2][2][4][2], const Unit& u, int wr, int wc, int fr, int fq) const {
        typedef float f2 __attribute__((ext_vector_type(2)));
        const int row0 = u.pm * BM + wr * 64 + fr, ch0 = u.pn * HALF + wc * 32 + 8 * fq;
        float rstd[8]; row_rstd8(ssq, inv_k, rs, last_pm, u, wr, wc, fr, fq, rstd);
#pragma unroll
        for (int ai = 0; ai < 2; ++ai)
#pragma unroll
            for (int m = 0; m < 4; ++m) {
                const int row = row0 + ai * HALF + m * 16;
                const float rg = rstd[ai * 4 + m] * 1.4426950408889634f, ru = rstd[ai * 4 + m] * 0.6931471805599453f;
                const f2 rg2 = {rg, rg}, ru2 = {ru, ru};
                unsigned w[4];
#pragma unroll
                for (int n = 0; n < 2; ++n)
#pragma unroll
                    for (int p = 0; p < 2; ++p) {
                        const f2 gl = (f2){acc[ai][0][m][n][2 * p], acc[ai][0][m][n][2 * p + 1]} * rg2, up = (f2){acc[ai][1][m][n][2 * p], acc[ai][1][m][n][2 * p + 1]} * ru2;
                        f2 d = {__builtin_amdgcn_exp2f(-gl.x), __builtin_amdgcn_exp2f(-gl.y)}; d = d + (f2){1.f, 1.f};
                        const f2 sg = {__builtin_amdgcn_rcpf(d.x), __builtin_amdgcn_rcpf(d.y)};
                        const f2 o = (gl * sg) * up;
                        w[n * 2 + p] = cvt_pk_bf16(o.x, o.y);
                    }
                *(u32x4*)(O + (size_t)row * ldc + ch0) = (u32x4){w[0], w[1], w[2], w[3]};
            }
    }
};
struct EpiProj {
    static constexpr bool PERM = true, AFTER_DRAIN = false;
    bf16_t* O; int ldc; const float* ssq; float inv_k; PG8_LAS float* rs; mutable int last_pm;
    __device__ __forceinline__ void operator()(const f32x4 (&acc)[2][2][4][2], const Unit& u, int wr, int wc, int fr, int fq) const {
        const int row0 = u.pm * BM + wr * 64 + fr, col0 = u.pn * BM + wc * 32 + 8 * fq;
        float rstd8[8]; row_rstd8(ssq, inv_k, rs, last_pm, u, wr, wc, fr, fq, rstd8);
#pragma unroll
        for (int ai = 0; ai < 2; ++ai)
#pragma unroll
            for (int m = 0; m < 4; ++m) {
                const int row = row0 + ai * HALF + m * 16;
                const float rstd = rstd8[ai * 4 + m];
#pragma unroll
                for (int bj = 0; bj < 2; ++bj) {
                    const f32x4 v0 = acc[ai][bj][m][0] * rstd, v1 = acc[ai][bj][m][1] * rstd;
                    u32x4 w; w.x = cvt_pk_bf16(v0[0], v0[1]); w.y = cvt_pk_bf16(v0[2], v0[3]); w.z = cvt_pk_bf16(v1[0], v1[1]); w.w = cvt_pk_bf16(v1[2], v1[3]);
                    *(u32x4*)(O + (size_t)row * ldc + col0 + bj * HALF) = w;
                }
            }
    }
};
struct EpiResid {
    static constexpr bool PERM = true, AFTER_DRAIN = false;
    float* xout32; bf16_t* xb; float* ssq_out; int ldx; float scale;
    const bf16_t* wab; float* abp;
    __device__ __forceinline__ void operator()(const f32x4 (&acc)[2][2][4][2], const Unit& u, int wr, int wc, int fr, int fq) const {
        const int row0 = u.pm * BM + wr * 64 + fr, col0 = u.pn * BM + wc * 32 + 8 * fq;
        bf16x8 wfr[2] = {};
        if (wab) { wfr[0] = *(const bf16x8*)(wab + (size_t)fr * ldx + col0); wfr[1] = *(const bf16x8*)(wab + (size_t)fr * ldx + col0 + HALF); }
        auto finish = [&](const int ai, const int m, const f32x4 (&x)[2][2]) {
            const int row = row0 + ai * HALF + m * 16;
            float ss = 0.f; f32x4 ab = {0.f, 0.f, 0.f, 0.f};
#pragma unroll
            for (int bj = 0; bj < 2; ++bj) {
                const size_t off = (size_t)row * ldx + col0 + bj * HALF;
                const f32x4 v0 = x[bj][0] + acc[ai][bj][m][0] * scale, v1 = x[bj][1] + acc[ai][bj][m][1] * scale;
                if (xout32) { *(f32x4*)(xout32 + off) = v0; *(f32x4*)(xout32 + off + 4) = v1; }
                u32x4 w; w.x = cvt_pk_bf16(v0[0], v0[1]); w.y = cvt_pk_bf16(v0[2], v0[3]); w.z = cvt_pk_bf16(v1[0], v1[1]); w.w = cvt_pk_bf16(v1[2], v1[3]);
                *(u32x4*)(xb + off) = w;
                if (wab) ab = __builtin_amdgcn_mfma_f32_16x16x32_bf16(wfr[bj], __builtin_bit_cast(bf16x8, w), ab, 0, 0, 0);
                { typedef float f2 __attribute__((ext_vector_type(2)));
                  const f2 a = {v0[0], v0[1]}, b2 = {v0[2], v0[3]}, c = {v1[0], v1[1]}, d = {v1[2], v1[3]}; f2 q = a * a; q = b2 * b2 + q; q = c * c + q; q = d * d + q; ss += q.x + q.y; }
            }
            ss += __shfl_xor(ss, 16); ss += __shfl_xor(ss, 32);
            if (fq == 0) ssq_out[(size_t)row * 16 + u.pn * 4 + wc] = ss;
            if (wab && fq < 2) *(f32x4*)(abp + (size_t)row * 128 + (u.pn * 4 + wc) * 8 + 4 * fq) = ab;
        };
#pragma unroll
        for (int ai = 0; ai < 2; ++ai) {
            u32x4 xo[4][2];
#pragma unroll
            for (int m = 0; m < 4; ++m)
#pragma unroll
                for (int bj = 0; bj < 2; ++bj) xo[m][bj] = *(const u32x4*)(xb + (size_t)(row0 + ai * HALF + m * 16) * ldx + col0 + bj * HALF);
#pragma unroll
            for (int m = 0; m < 4; ++m) {
                f32x4 x[2][2];
#pragma unroll
                for (int bj = 0; bj < 2; ++bj) { const u32x4 o = xo[m][bj];
                    x[bj][0] = (f32x4){__builtin_bit_cast(float, o.x << 16), __builtin_bit_cast(float, o.x & 0xffff0000u), __builtin_bit_cast(float, o.y << 16), __builtin_bit_cast(float, o.y & 0xffff0000u)};
                    x[bj][1] = (f32x4){__builtin_bit_cast(float, o.z << 16), __builtin_bit_cast(float, o.z & 0xffff0000u), __builtin_bit_cast(float, o.w << 16), __builtin_bit_cast(float, o.w & 0xffff0000u)}; }
                finish(ai, m, x);
            }
        }
    }
};
struct EpiFinal {
    static constexpr bool PERM = true, AFTER_DRAIN = false;
    float* out; const bf16_t* xb; float* part; unsigned* cnt; const float* gain; int ldx; float scale; unsigned* tmo;
    __device__ __forceinline__ void operator()(f32x4 (&acc)[2][2][4][2], const Unit& u, int wr, int wc, int fr, int fq) const {
        const int row0 = u.pm * BM + wr * 64 + fr, col0 = u.pn * BM + wc * 32 + 8 * fq;
#pragma unroll
        for (int ai = 0; ai < 2; ++ai) {
            u32x4 xo[4][2];
#pragma unroll
            for (int m = 0; m < 4; ++m)
#pragma unroll
                for (int bj = 0; bj < 2; ++bj) xo[m][bj] = *(const u32x4*)(xb + (size_t)(row0 + ai * HALF + m * 16) * ldx + col0 + bj * HALF);
#pragma unroll
            for (int m = 0; m < 4; ++m) {
                const int row = row0 + ai * HALF + m * 16;
                float ss = 0.f;
#pragma unroll
                for (int bj = 0; bj < 2; ++bj) {
                    const u32x4 o = xo[m][bj];
                    const f32x4 x0 = {__builtin_bit_cast(float, o.x << 16), __builtin_bit_cast(float, o.x & 0xffff0000u), __builtin_bit_cast(float, o.y << 16), __builtin_bit_cast(float, o.y & 0xffff0000u)};
                    const f32x4 x1 = {__builtin_bit_cast(float, o.z << 16), __builtin_bit_cast(float, o.z & 0xffff0000u), __builtin_bit_cast(float, o.w << 16), __builtin_bit_cast(float, o.w & 0xffff0000u)};
                    const f32x4 v0 = x0 + acc[ai][bj][m][0] * scale, v1 = x1 + acc[ai][bj][m][1] * scale;
                    acc[ai][bj][m][0] = v0; acc[ai][bj][m][1] = v1;
                    { typedef float f2 __attribute__((ext_vector_type(2)));
                      const f2 a = {v0[0], v0[1]}, b2 = {v0[2], v0[3]}, c = {v1[0], v1[1]}, d = {v1[2], v1[3]}; f2 q = a * a; q = b2 * b2 + q; q = c * c + q; q = d * d + q; ss += q.x + q.y; }
                }
                ss += __shfl_xor(ss, 16); ss += __shfl_xor(ss, 32);
                if (fq == 0) asm volatile("global_store_dword %0, %1, off sc1\n\ts_nop 1" :: "v"(part + (size_t)row * 16 + u.pn * 4 + wc), "v"(ss) : "memory");
            }
        }
        asm volatile("s_waitcnt vmcnt(0)" ::: "memory");
        __builtin_amdgcn_s_barrier();
        if (wr == 0 && wc == 0 && fr == 0 && fq == 0) {
            unsigned* c = cnt + 64 * u.pm; __hip_atomic_fetch_add(c, 1u, __ATOMIC_RELAXED, __HIP_MEMORY_SCOPE_AGENT);
            unsigned sp = 0;
            while (__hip_atomic_load(c, __ATOMIC_RELAXED, __HIP_MEMORY_SCOPE_AGENT) < 4u) { __builtin_amdgcn_s_sleep(1); if (++sp > (1u << 22)) { __hip_atomic_store(tmo, 1u, __ATOMIC_RELAXED, __HIP_MEMORY_SCOPE_AGENT); break; } }
        }
        __builtin_amdgcn_s_barrier();
        f32x4 g[2][2];
#pragma unroll
        for (int bj = 0; bj < 2; ++bj) { g[bj][0] = *(const f32x4*)(gain + col0 + bj * HALF); g[bj][1] = *(const f32x4*)(gain + col0 + bj * HALF + 4); }
#pragma unroll
        for (int ai = 0; ai < 2; ++ai) {
            f32x4 p0, p1, p2, p3; const float* pa = part + (size_t)(row0 + ai * HALF) * 16 + 4 * fq;
            asm volatile("global_load_dwordx4 %0, %4, off sc1\n\tglobal_load_dwordx4 %1, %4, off offset:1024 sc1\n\tglobal_load_dwordx4 %2, %4, off offset:2048 sc1\n\tglobal_load_dwordx4 %3, %4, off offset:3072 sc1\n\ts_waitcnt vmcnt(0)"
                         : "=&v"(p0), "=&v"(p1), "=&v"(p2), "=&v"(p3) : "v"(pa) : "memory");
#pragma unroll
            for (int m = 0; m < 4; ++m) {
                const f32x4 p = m == 0 ? p0 : m == 1 ? p1 : m == 2 ? p2 : p3;
                float s = (p.x + p.y) + (p.z + p.w); s += __shfl_xor(s, 16); s += __shfl_xor(s, 32);
                const float rstd = __builtin_amdgcn_rsqf(s * (1.f / 1024.f) + RMS_EPS);
                const int row = row0 + ai * HALF + m * 16;
#pragma unroll
                for (int bj = 0; bj < 2; ++bj) { float* op = out + (size_t)row * ldx + col0 + bj * HALF;
                    *(f32x4*)op = acc[ai][bj][m][0] * rstd * g[bj][0]; *(f32x4*)(op + 4) = acc[ai][bj][m][1] * rstd * g[bj][1]; }
            }
        }
    }
};

template <class Epi, class Sched, bool ALIGN_EPI = false, bool SP2 = false>
__device__ __forceinline__ void gemm_phase(PG8_LAS unsigned char* lds, const Gemm g, const Sched& S, const Epi& E) {
    int tid_ = threadIdx.x; asm volatile("" : "+v"(tid_));
    const int tid = tid_, wid = __builtin_amdgcn_readfirstlane(tid >> 6), lane = tid & 63, wr = wid >> 2, wc = wid & 3, fr = lane & 15, fq = lane >> 4;
    const int K = g.K, nt = K / BK, lda = g.lda;
    unsigned voffA[2], voffB[2];
#pragma unroll
    for (int i = 0; i < 2; ++i) { int R, C; stage_rc(tid * 16 + i * 8192, R, C); const int Rb = Epi::PERM ? ((R & ~31) + perm32(R & 31)) : R;
        voffA[i] = (unsigned)(R * lda + C) * 2u; voffB[i] = (unsigned)(Rb * K + C) * 2u; }
    const size_t kstep = (size_t)(BK * 2);
    const size_t hstepA = (size_t)HALF * lda * 2, hstepB = (size_t)HALF * K * 2;
    const size_t tstepA = 2 * hstepA, tstepB = 2 * hstepB;
    const unsigned ldsw = (unsigned)wid * 1024u;
    const int aoff = lds_byte(wr * 64 + fr, fq * 8), boff = lds_byte(wc * 32 + fr, fq * 8);
#define PG8_SA(b, h) (((b) * 2 + (h)) * HTB)
#define PG8_SB(b, h) ((4 + (b) * 2 + (h)) * HTB)
#define PG8_STAGE(bufoff, gbase, voff) do { _Pragma("unroll") for (int _i = 0; _i < 2; ++_i) \
        __builtin_amdgcn_global_load_lds((const unsigned*)((const char*)(gbase) + (voff)[_i]), (PG8_LAS unsigned*)(lds + (bufoff) + ldsw + _i * 8192), 16, 0, 0); } while (0)
#define PG8_LDA(dst, b, h) do { _Pragma("unroll") for (int m = 0; m < 4; ++m) _Pragma("unroll") for (int k = 0; k < 2; ++k) dst[m][k] = *(const PG8_LAS bf16x8*)(lds + PG8_SA(b, h) + aoff + m * 2048 + k * 1024); } while (0)
#define PG8_LDB(dst, b, h) do { _Pragma("unroll") for (int n = 0; n < 2; ++n) _Pragma("unroll") for (int k = 0; k < 2; ++k) dst[n][k] = *(const PG8_LAS bf16x8*)(lds + PG8_SB(b, h) + boff + n * 2048 + k * 1024); } while (0)
#define PG8_MMA(ai, bj, At, Bt) do { __builtin_amdgcn_s_setprio(1); _Pragma("unroll") for (int m = 0; m < 4; ++m) _Pragma("unroll") for (int n = 0; n < 2; ++n) _Pragma("unroll") for (int k = 0; k < 2; ++k) \
        acc[ai][bj][m][n] = __builtin_amdgcn_mfma_f32_16x16x32_bf16(Bt[n][k], At[m][k], acc[ai][bj][m][n], 0, 0, 0); __builtin_amdgcn_s_setprio(0); } while (0)
#define PG8_WAIT_V(n) asm volatile("s_waitcnt vmcnt(" #n ")" ::: "memory")
#define PG8_WAIT_L(n) asm volatile("s_waitcnt lgkmcnt(" #n ")" ::: "memory")
#define PG8_BAR __builtin_amdgcn_s_barrier()
#define PG8_SCHED __builtin_amdgcn_sched_barrier(0)
    Unit cur, nxt; int ui = 0;
    if (!S.next(0, cur)) return;
    f32x4 acc[2][2][4][2];
#pragma unroll
    for (int a = 0; a < 2; ++a)
#pragma unroll
        for (int b = 0; b < 2; ++b)
#pragma unroll
            for (int m = 0; m < 4; ++m)
#pragma unroll
                for (int n = 0; n < 2; ++n) acc[a][b][m][n] = (f32x4){0.f, 0.f, 0.f, 0.f};
    bf16x8 At[4][2], B0[2][2], B1[2][2];
    const char* cA = (const char*)g.A + (size_t)cur.pm * tstepA; const char* cB = (const char*)g.Bt + (size_t)cur.pn * tstepB;
    S.a_ready(cur);
    if constexpr (SP2) {
        PG8_STAGE(PG8_SB(0, 0), cB, voffB); PG8_STAGE(PG8_SB(0, 1), cB + hstepB, voffB); PG8_STAGE(PG8_SA(0, 0), cA, voffA); PG8_STAGE(PG8_SA(0, 1), cA + hstepA, voffA);
        if (wr == 1) PG8_BAR;
        PG8_WAIT_V(2); PG8_BAR;
        PG8_STAGE(PG8_SB(1, 0), cB + kstep, voffB); PG8_STAGE(PG8_SA(1, 0), cA + kstep, voffA); PG8_STAGE(PG8_SB(1, 1), cB + hstepB + kstep, voffB);
        PG8_WAIT_V(6); PG8_BAR;
    } else {
        PG8_STAGE(PG8_SB(0, 0), cB, voffB); PG8_STAGE(PG8_SA(0, 0), cA, voffA); PG8_STAGE(PG8_SB(0, 1), cB + hstepB, voffB); PG8_STAGE(PG8_SA(0, 1), cA + hstepA, voffA);
        if (wr == 1) PG8_BAR;
        PG8_WAIT_V(4); PG8_BAR;
        PG8_STAGE(PG8_SB(1, 0), cB + kstep, voffB); PG8_STAGE(PG8_SA(1, 0), cA + kstep, voffA); PG8_STAGE(PG8_SB(1, 1), cB + hstepB + kstep, voffB);
        PG8_WAIT_V(6); PG8_BAR;
    }
    for (;;) {
        const bool has_next = S.next(ui + 1, nxt);
        const char* nA = has_next ? (const char*)g.A + (size_t)nxt.pm * tstepA : cA; const char* nB = has_next ? (const char*)g.Bt + (size_t)nxt.pn * tstepB : cB;
        for (int t = 0; t < nt; t += 2) {
            const bool last = (t == nt - 2);
            const char* a1 = cA + (size_t)(t + 1) * kstep;
            const char* a2 = last ? nA : cA + (size_t)(t + 2) * kstep; const char* b2 = last ? nB : cB + (size_t)(t + 2) * kstep;
            const char* a3 = a2 + kstep; const char* b3 = b2 + kstep;
            if (last && has_next) S.a_ready(nxt);
            if constexpr (SP2) {
            PG8_LDB(B0, 0, 0); PG8_LDB(B1, 0, 1); PG8_SCHED; PG8_LDA(At, 0, 0); PG8_STAGE(PG8_SA(1, 1), a1 + hstepA, voffA);
            PG8_WAIT_V(8); PG8_WAIT_L(0); PG8_BAR; PG8_MMA(0, 0, At, B0); PG8_MMA(0, 1, At, B1); PG8_BAR; PG8_SCHED;
            PG8_LDA(At, 0, 1); PG8_STAGE(PG8_SB(0, 0), b2, voffB); PG8_STAGE(PG8_SB(0, 1), b2 + hstepB, voffB); PG8_STAGE(PG8_SA(0, 0), a2, voffA);
            PG8_WAIT_V(8); PG8_WAIT_L(0); PG8_BAR; PG8_MMA(1, 0, At, B0); PG8_MMA(1, 1, At, B1); PG8_BAR; PG8_SCHED;
            PG8_LDB(B0, 1, 0); PG8_LDB(B1, 1, 1); PG8_SCHED; PG8_LDA(At, 1, 0); PG8_STAGE(PG8_SA(0, 1), a2 + hstepA, voffA);
            PG8_WAIT_V(8); PG8_WAIT_L(0); PG8_BAR; PG8_MMA(0, 0, At, B0); PG8_MMA(0, 1, At, B1); PG8_BAR; PG8_SCHED;
            PG8_LDA(At, 1, 1); PG8_STAGE(PG8_SB(1, 0), b3, voffB); PG8_STAGE(PG8_SB(1, 1), b3 + hstepB, voffB); PG8_STAGE(PG8_SA(1, 0), a3, voffA);
            PG8_WAIT_V(8); PG8_WAIT_L(0); PG8_BAR; PG8_MMA(1, 0, At, B0); PG8_MMA(1, 1, At, B1); PG8_BAR; PG8_SCHED;
            } else {
            PG8_LDB(B0, 0, 0); PG8_SCHED; PG8_LDA(At, 0, 0); PG8_STAGE(PG8_SA(1, 1), a1 + hstepA, voffA);
            PG8_WAIT_L(8); PG8_BAR; PG8_WAIT_L(0); PG8_MMA(0, 0, At, B0); PG8_BAR; PG8_SCHED;
            PG8_LDB(B1, 0, 1); PG8_STAGE(PG8_SB(0, 0), b2, voffB);
            PG8_BAR; PG8_WAIT_L(0); PG8_MMA(0, 1, At, B1); PG8_BAR;
            PG8_LDA(At, 0, 1); PG8_STAGE(PG8_SA(0, 0), a2, voffA);
            PG8_BAR; PG8_WAIT_L(0); PG8_MMA(1, 0, At, B0); PG8_BAR; PG8_SCHED;
            PG8_STAGE(PG8_SB(0, 1), b2 + hstepB, voffB);
            PG8_WAIT_V(6); PG8_BAR; PG8_MMA(1, 1, At, B1); PG8_BAR;
            PG8_LDB(B0, 1, 0); PG8_SCHED; PG8_LDA(At, 1, 0); PG8_STAGE(PG8_SA(0, 1), a2 + hstepA, voffA);
            PG8_WAIT_L(8); PG8_BAR; PG8_WAIT_L(0); PG8_MMA(0, 0, At, B0); PG8_BAR; PG8_SCHED;
            PG8_LDB(B1, 1, 1); PG8_STAGE(PG8_SB(1, 0), b3, voffB);
            PG8_BAR; PG8_WAIT_L(0); PG8_MMA(0, 1, At, B1); PG8_BAR;
            PG8_LDA(At, 1, 1); PG8_STAGE(PG8_SA(1, 0), a3, voffA);
            PG8_BAR; PG8_WAIT_L(0); PG8_MMA(1, 0, At, B0); PG8_BAR; PG8_SCHED;
            PG8_STAGE(PG8_SB(1, 1), b3 + hstepB, voffB);
            PG8_WAIT_V(6); PG8_BAR; PG8_MMA(1, 1, At, B1); PG8_BAR;
            }
        }
        if constexpr (ALIGN_EPI) { if (wr == 0) PG8_BAR; }
        if constexpr (!Epi::AFTER_DRAIN) { E(acc, cur, wr, wc, fr, fq); S.done(cur); }
        if (!has_next) break;
#pragma unroll
        for (int a = 0; a < 2; ++a)
#pragma unroll
            for (int b = 0; b < 2; ++b)
#pragma unroll
                for (int m = 0; m < 4; ++m)
#pragma unroll
                    for (int n = 0; n < 2; ++n) acc[a][b][m][n] = (f32x4){0.f, 0.f, 0.f, 0.f};
        cur = nxt; cA = nA; cB = nB; ++ui;
        if constexpr (ALIGN_EPI) { if (wr == 1) PG8_BAR; }
    }
    PG8_WAIT_V(0);
    if constexpr (!ALIGN_EPI) { if (wr == 0) PG8_BAR; }
    PG8_BAR;
#undef PG8_SA
#undef PG8_SB
#undef PG8_STAGE
#undef PG8_LDA
#undef PG8_LDB
#undef PG8_MMA
#undef PG8_WAIT_V
#undef PG8_WAIT_L
#undef PG8_BAR
#undef PG8_SCHED
}
}

#ifndef DIAG
#define DIAG 0
#endif
#ifndef HGRN_CHUNKED
#define HGRN_CHUNKED 1
#endif
#ifndef RET_CHUNKED
#define RET_CHUNKED 1
#endif
#ifndef GDN_CHUNKED
#define GDN_CHUNKED 1
#endif
#ifndef DIAG_A
#define DIAG_A 4
#define DIAG_B 1
#endif
constexpr int NWAVES = 8, NTHR = NWAVES * 64;
constexpr int BATCH = 16, SEQ = 2048, DM = 1024, DEPTH = 4, NH = 4;
constexpr int M = BATCH * SEQ;
constexpr int DFF = 2816, NFI = 2 * DFF;
constexpr int NMIX_G = 3584;
constexpr int NMIX_SRC = 3592, NMIX = 3840;
constexpr int CHUNK = 64, NCHUNK = SEQ / CHUNK;
constexpr float EPS = 1e-6f;
constexpr int C_AQ = 0, C_BQ = 256, C_CQ = 512, C_DQK = 768, C_AF = 1024, C_AI = 1280, C_AG = 1536, C_BK = 1792, C_BV = 2048, C_BG = 2304,
              C_CK = 2560, C_CV = 2816, C_DV = 3072, C_DG = 3328, C_BA = 3584, C_BB = 3588, C_GB = 3600;
constexpr int Y_A = 0, Y_B = 256, Y_C = 512, Y_D = 768;
constexpr int XB_Q = 0, XB_K = 256, XB_V = 512, XB_GB = 768;

constexpr size_t MiB = 1u << 20;
constexpr size_t WS_CTL = 0, CTL_ZERO_BYTES = 192 * 1024;
constexpr size_t WS_ROPE = 1 * MiB;
constexpr size_t WS_SSQ = 2 * MiB;
constexpr size_t WS_W = 4 * MiB;
constexpr size_t W_FI = (size_t)NFI * DM * 2, W_FO = (size_t)DM * DFF * 2, W_MI = (size_t)NMIX * DM * 2, W_MO = (size_t)DM * DM * 2;
constexpr size_t WL_FI1 = 0, WL_FO1 = WL_FI1 + W_FI, WL_FI2 = WL_FO1 + W_FO, WL_FO2 = WL_FI2 + W_FI, WL_MI = WL_FO2 + W_FO, WL_MO = WL_MI + W_MI, WL_BYTES = WL_MO + W_MO;
constexpr size_t WS_XB = 176 * MiB;
constexpr size_t WS_BIG = 240 * MiB;
constexpr size_t WS_GDN = 480 * MiB;
constexpr size_t WS_END = 512 * MiB;
constexpr size_t OUT_ABP = 64 * MiB;
static_assert(WS_W + DEPTH * WL_BYTES <= WS_XB && WS_XB + (size_t)M * DM * 2 <= WS_BIG && WS_BIG + (size_t)M * NMIX * 2 <= WS_END, "d_ws map");
constexpr int CW_TMO = 0, CW_CODE = 1, CW_XMAP = 256;
constexpr int CW_BAR = 4096;
constexpr int CW_QUEUE = 8192;
constexpr int CW_FIN = 32768;
constexpr int CW_GDN = 16384;
static_assert((size_t)(CW_FIN + 64 * (M / 256)) * 4 <= CTL_ZERO_BYTES && (size_t)(CW_QUEUE + 64 * DEPTH) * 4 <= CTL_ZERO_BYTES && (size_t)(CW_GDN + 64 * 64 * DEPTH) * 4 <= CTL_ZERO_BYTES && WS_SSQ + (size_t)M * 16 * 4 <= WS_W, "CTL words inside the memset region");

constexpr int RING_OFF = 0, RING_BYTES = 139264;
constexpr int LDSCTL_OFF = RING_BYTES, MISC_OFF = LDSCTL_OFF + 320;
constexpr int RS_OFF = RING_BYTES + 1024;
constexpr int LDS_BYTES = 147456;
static_assert(RS_OFF + 4096 <= LDS_BYTES, "LDS map");

#define GAS __attribute__((address_space(1)))
#define LAS __attribute__((address_space(3)))
typedef unsigned short bf16;
typedef unsigned v4u __attribute__((ext_vector_type(4)));
typedef float f32x4 __attribute__((ext_vector_type(4)));
typedef float f32x2 __attribute__((ext_vector_type(2)));
typedef GAS unsigned gu32;
#define RLX_AGENT __ATOMIC_RELAXED, __HIP_MEMORY_SCOPE_AGENT
#define LDS_WAIT() asm volatile("s_waitcnt lgkmcnt(0)" ::: "memory")
#define LDS_BARRIER() asm volatile("s_waitcnt lgkmcnt(0)\n\ts_barrier" ::: "memory")
#define VM_WAIT() asm volatile("s_waitcnt vmcnt(0)" ::: "memory")
typedef __bf16 bf16x2_t __attribute__((ext_vector_type(2)));
__device__ __forceinline__ unsigned pk2(float lo, float hi) { f32x2 v = {lo, hi}; bf16x2_t b = __builtin_convertvector(v, bf16x2_t); return __builtin_bit_cast(unsigned, b); }
__device__ __forceinline__ unsigned f2bf(float f) { return pk2(f, 0.f) & 0xffffu; }
__device__ __forceinline__ float bflo(unsigned u) { return __builtin_bit_cast(float, u << 16); }
__device__ __forceinline__ float bfhi(unsigned u) { return __builtin_bit_cast(float, u & 0xffff0000u); }
__device__ __forceinline__ float fexp(float x) { return __builtin_amdgcn_exp2f(x * 1.4426950408889634f); }
__device__ __forceinline__ float fsigmoid(float x) { return __builtin_amdgcn_rcpf(1.f + fexp(-x)); }
__device__ __forceinline__ float fsilu(float x) { return x * fsigmoid(x); }

#define XB_TMO      128
#define XB_XCNT(j)  (256  + 64 * (j))
#define XB_XSUB(j)  (1280 + 64 * (j))
#define XB_XGEN(j)  (2304 + 64 * (j))
#define XB_TOP      3328
#define XB_TOPGEN   3392
#define XCD_BAR_WORDS 3456
#define XB_SPIN_CAP (1u << 20)

__device__ __forceinline__ unsigned xb_ld(unsigned* p)              { return __hip_atomic_load(p, __ATOMIC_RELAXED, __HIP_MEMORY_SCOPE_AGENT); }
__device__ __forceinline__ unsigned xb_add(unsigned* p, unsigned v) { return __hip_atomic_fetch_add(p, v, __ATOMIC_RELAXED, __HIP_MEMORY_SCOPE_AGENT); }
__device__ __forceinline__ unsigned xb_xcc_id() { return (unsigned)__builtin_amdgcn_s_getreg((3 << 11) | 20) & 0xFu; }
#define XB_SPIN(cond, bar) do { unsigned _sp = 0; while (cond) { __builtin_amdgcn_s_sleep(1); \
    if ((++_sp & 255u) == 0u) { if (xb_ld(&(bar)[XB_TMO])) break; if (_sp > XB_SPIN_CAP) { atomicAdd(&(bar)[XB_TMO], 1u); break; } } } } while (0)

struct XcdBarrier {
    unsigned* bar; unsigned x;
    volatile LAS unsigned* st;
};
__device__ __forceinline__ XcdBarrier xcd_barrier_post(unsigned* bar, volatile LAS unsigned* st) {
    XcdBarrier b; b.bar = bar; b.x = xb_xcc_id(); b.st = st;
    if (threadIdx.x == 0) (void)xb_add(&bar[XB_XCNT(b.x)], 1u);
    return b;
}
__device__ __forceinline__ void xcd_barrier_complete(unsigned* bar, unsigned x, unsigned& nloc, unsigned& nx) {
    const unsigned G = gridDim.x * gridDim.y * gridDim.z;
    unsigned sum, cnt, mine, sp = 0u;
    for (;;) {
        sum = 0u; cnt = 0u; mine = 0u;
#pragma unroll
        for (unsigned j = 0; j < 16; ++j) { const unsigned c = xb_ld(&bar[XB_XCNT(j)]); sum += c; cnt += (c > 0u) ? 1u : 0u; mine = (j == x) ? c : mine; }
        if (sum == G) break;
        __builtin_amdgcn_s_sleep(1);
        if ((++sp & 255u) == 0u) { if (xb_ld(&bar[XB_TMO])) break; if (sp > XB_SPIN_CAP) { atomicAdd(&bar[XB_TMO], 1u); break; } }
    }
    nloc = mine > 0u ? mine : 1u; nx = cnt > 0u ? cnt : 1u;
}
__device__ __forceinline__ void xcd_barrier(const XcdBarrier& b) {
    asm volatile("s_waitcnt vmcnt(0)" ::: "memory");
    __syncthreads();
    if (threadIdx.x == 0) {
        unsigned* bar = b.bar;
        __builtin_amdgcn_s_waitcnt(0);
        unsigned nloc = b.st[0], nx = b.st[1];
        if (nloc == 0u) { xcd_barrier_complete(bar, b.x, nloc, nx); b.st[0] = nloc; b.st[1] = nx; }
        const unsigned old = xb_add(&bar[XB_XSUB(b.x)], 1u);
        const unsigned gen = old / nloc;
        if (old + 1u == (gen + 1u) * nloc) {
            __builtin_amdgcn_fence(__ATOMIC_RELEASE, "agent");
            asm volatile("s_waitcnt vmcnt(0)" ::: "memory");
            const unsigned og = xb_add(&bar[XB_TOP], 1u);
            const unsigned tg = og / nx;
            if (og + 1u == (tg + 1u) * nx) xb_add(&bar[XB_TOPGEN], 1u);
            else XB_SPIN(xb_ld(&bar[XB_TOPGEN]) == tg, bar);
            __builtin_amdgcn_fence(__ATOMIC_ACQUIRE, "agent");
            xb_add(&bar[XB_XGEN(b.x)], 1u);
            asm volatile("s_waitcnt vmcnt(0)" ::: "memory");
        } else {
            XB_SPIN(xb_ld(&bar[XB_XGEN(b.x)]) == gen, bar);
            __builtin_amdgcn_fence(__ATOMIC_ACQUIRE, "agent");
            asm volatile("s_waitcnt vmcnt(0)" ::: "memory");
        }
    }
    __syncthreads();
}

__device__ __forceinline__ void xcd_local_barrier(const XcdBarrier& b) {
    asm volatile("s_waitcnt vmcnt(0)" ::: "memory");
    __syncthreads();
    if (threadIdx.x == 0) {
        unsigned* bar = b.bar;
        __builtin_amdgcn_s_waitcnt(0);
        const unsigned nloc = b.st[0];
        const unsigned old = xb_add(&bar[XB_XSUB(b.x)], 1u);
        const unsigned gen = old / nloc;
        if (old + 1u == (gen + 1u) * nloc) {
            xb_add(&bar[XB_XGEN(b.x)], 1u);
            __builtin_amdgcn_fence(__ATOMIC_ACQUIRE, "agent");
            asm volatile("s_waitcnt vmcnt(0)" ::: "memory");
        } else {
            XB_SPIN(xb_ld(&bar[XB_XGEN(b.x)]) == gen, bar);
            __builtin_amdgcn_fence(__ATOMIC_ACQUIRE, "agent");
            asm volatile("s_waitcnt vmcnt(0)" ::: "memory");
        }
    }
    __syncthreads();
}

struct Frame {
    LAS unsigned char* lds;
    volatile LAS unsigned* MISC;
    gu32* ctl;
    int vcu, G;
};
__device__ __forceinline__ float wave_sum(float v) {
#pragma unroll
    for (int o = 1; o < 64; o <<= 1) v += __shfl_xor(v, o);
    return v;
}
template <int CTRL> __device__ __forceinline__ float dppf(float x) { return __builtin_bit_cast(float, __builtin_amdgcn_update_dpp(0, __builtin_bit_cast(int, x), CTRL, 0xF, 0xF, true)); }
__device__ __forceinline__ float red8(float x) {
    x += dppf<0xB1>(x);
    x += dppf<0x4E>(x);
    x += dppf<0x141>(x);
    return x;
}

#define OPAQUE_TID() int tid = threadIdx.x; asm volatile("" : "+v"(tid)); const int lane = tid & 63, wave = __builtin_amdgcn_readfirstlane(tid >> 6); (void)lane; (void)wave
__device__ __forceinline__ int mix_src_col(int j0) {
    const int seg = j0 >> 8, r = j0 & 255;
    if (seg == 3) { const int h = r >> 6, part = (r >> 5) & 1; return (part ? 2952 : 2824) + 32 * h; }
    if (seg == 14) return r == 0 ? -2 : -1;
    const int base = seg == 0 ? 0 : seg == 1 ? 1024 : seg == 2 ? 2056 : seg == 4 ? 256 : seg == 5 ? 512 : seg == 6 ? 768 : seg == 7 ? 1280 : seg == 8 ? 1536 :
                     seg == 9 ? 1792 : seg == 10 ? 2312 : seg == 11 ? 2568 : seg == 12 ? 3080 : 3336;
    return base + r;
}
struct ConvItem { const float* W; const float* gain; bf16* WT; int K, Nsrc, k0, n0, srccol, nvalid; };
__device__ __forceinline__ void item_load(const ConvItem& d, int lane, float (&wv)[32]) {
    const int nl = lane & 31;
#pragma unroll
    for (int i = 0; i < 32; ++i) { const int kk = 2 * i + (lane >> 5); wv[i] = (nl < d.nvalid) ? __builtin_nontemporal_load(&d.W[(size_t)(d.k0 + kk) * d.Nsrc + d.srccol + nl]) : 0.f; }
    if (d.gain) {
#pragma unroll
        for (int i = 0; i < 32; ++i) wv[i] *= d.gain[d.k0 + 2 * i + (lane >> 5)]; }
}
__device__ __forceinline__ void item_finish(const ConvItem& d, int lane, const float (&wv)[32], LAS float* scr) {
    const int nl = lane & 31;
#pragma unroll
    for (int i = 0; i < 32; ++i) scr[(2 * i + (lane >> 5)) * 33 + nl] = wv[i];
    LDS_WAIT(); asm volatile("" ::: "memory");
    const int c = lane & 7;
#pragma unroll
    for (int j = 0; j < 4; ++j) { const int n = (lane >> 3) + 8 * j; const LAS float* s = scr + (8 * c) * 33 + n;
        v4u o; o.x = pk2(s[0 * 33], s[1 * 33]); o.y = pk2(s[2 * 33], s[3 * 33]); o.z = pk2(s[4 * 33], s[5 * 33]); o.w = pk2(s[6 * 33], s[7 * 33]);
        *(GAS v4u*)(d.WT + (size_t)(d.n0 + n) * d.K + d.k0 + 8 * c) = o; }
    LDS_WAIT(); asm volatile("" ::: "memory");
}

struct Args { const float* in[19]; float* out; unsigned char* ws; int ph_lo, ph_hi; };
enum { I_X = 0, I_F1N, I_F1WI, I_F1WO, I_MN, I_MWI, I_MWO, I_F2N, I_F2WI, I_F2WO, I_LB, I_HGN, I_CONV, I_ALOG, I_DTB, I_GDN, I_SBN, I_RETN, I_FN };

constexpr int IT_FI = (DM / 64) * (NFI / 32), IT_FO = (DFF / 64) * (DM / 32), IT_MI = (DM / 64) * (NMIX / 32), IT_MO = (DM / 64) * (DM / 32);
constexpr int IT_LAYER = 2 * IT_FI + 2 * IT_FO + IT_MI + IT_MO;
__device__ __forceinline__ ConvItem conv_desc(const Args& a, int l, int r) {
    bf16* wl = (bf16*)(a.ws + WS_W + (size_t)l * WL_BYTES);
    if (r < 2 * IT_FI) {
        const int half = r / IT_FI; r %= IT_FI;
        const int nb = r % (NFI / 32), kb = r / (NFI / 32), j0 = 32 * nb, pn = j0 >> 8, within = j0 & 255;
        const int src = within < 128 ? 128 * pn + within : DFF + 128 * pn + (within - 128);
        return ConvItem{(half ? a.in[I_F2WI] : a.in[I_F1WI]) + (size_t)l * DM * NFI, (half ? a.in[I_F2N] : a.in[I_F1N]) + l * DM, (bf16*)((char*)wl + (half ? WL_FI2 : WL_FI1)), DM, NFI, 64 * kb, j0, src, 32}; }
    r -= 2 * IT_FI;
    if (r < 2 * IT_FO) {
        const int half = r / IT_FO; r %= IT_FO;
        const int nb = r % (DM / 32), kb = r / (DM / 32);
        return ConvItem{(half ? a.in[I_F2WO] : a.in[I_F1WO]) + (size_t)l * DFF * DM, nullptr, (bf16*)((char*)wl + (half ? WL_FO2 : WL_FO1)), DFF, DM, 64 * kb, 32 * nb, 32 * nb, 32}; }
    r -= 2 * IT_FO;
    if (r < IT_MI) {
        const int nb = r % (NMIX / 32), kb = r / (NMIX / 32), j0 = 32 * nb; int src = mix_src_col(j0), nv = 32;
        if (src == -1) { src = 0; nv = 0; } else if (src == -2) { src = 2048; nv = 8; }
        return ConvItem{a.in[I_MWI] + (size_t)l * DM * NMIX_SRC, a.in[I_MN] + l * DM, (bf16*)((char*)wl + WL_MI), DM, NMIX_SRC, 64 * kb, j0, src, nv}; }
    r -= IT_MI;
    { const int nb = r % (DM / 32), kb = r / (DM / 32);
      return ConvItem{a.in[I_MWO] + (size_t)l * DM * DM, nullptr, (bf16*)((char*)wl + WL_MO), DM, DM, 64 * kb, 32 * nb, 32 * nb, 32}; }
}
__device__ __forceinline__ void convert_items(const Args& a, int l, int first, int stride, LAS float* scr, int lane) {
    for (int it = first; it < IT_LAYER; it += 2 * stride) {
        const bool two = it + stride < IT_LAYER;
        const ConvItem d0 = conv_desc(a, l, it), d1 = conv_desc(a, l, two ? it + stride : it);
        float w0[32], w1[32];
        item_load(d0, lane, w0);
        if (two) item_load(d1, lane, w1);
        item_finish(d0, lane, w0, scr);
        if (two) item_finish(d1, lane, w1, scr);
    }
}
constexpr int CONV_UNITS = 256;
__device__ __forceinline__ void convert_unit(Frame& F, const Args& a, int l, int cu) {
    OPAQUE_TID();
    LAS float* scr = (LAS float*)(F.lds + RING_OFF + wave * 16384);
    convert_items(a, l, cu * NWAVES + wave, CONV_UNITS * NWAVES, scr, lane);
    __syncthreads();
}
__device__ __forceinline__ void p0_prologue(Frame& F, const Args& a) {
    OPAQUE_TID();
    LAS float* scr = (LAS float*)(F.lds + RING_OFF + wave * 16384);
    const int gw = F.vcu * NWAVES + wave, NGW = F.G * NWAVES;
    convert_items(a, 0, gw, NGW, scr, lane);
    {
        const float* x = a.in[I_X]; bf16* xb = (bf16*)(a.ws + WS_XB); float* ssq0 = (float*)(a.ws + WS_SSQ);
        for (int m0 = gw; m0 < M; m0 += 8 * NGW) {
            f32x4 v[8][4];
#pragma unroll
            for (int r = 0; r < 8; ++r) { const int m = m0 + r * NGW;
                if (m < M) { const GAS f32x4* xr = (const GAS f32x4*)(x + (size_t)m * DM) + lane;
#pragma unroll
                    for (int j = 0; j < 4; ++j) v[r][j] = xr[64 * j]; } }
#pragma unroll
            for (int r = 0; r < 8; ++r) { const int m = m0 + r * NGW;
                if (m < M) {
                    float s = 0.f;
#pragma unroll
                    for (int j = 0; j < 4; ++j) s += (v[r][j].x * v[r][j].x + v[r][j].y * v[r][j].y) + (v[r][j].z * v[r][j].z + v[r][j].w * v[r][j].w);
                    s = wave_sum(s);
                    GAS unsigned long long* o8 = (GAS unsigned long long*)(xb + (size_t)m * DM) + lane;
#pragma unroll
                    for (int j = 0; j < 4; ++j) o8[64 * j] = (unsigned long long)pk2(v[r][j].x, v[r][j].y) | ((unsigned long long)pk2(v[r][j].z, v[r][j].w) << 32);
                    if (lane < 16) ssq0[(size_t)m * 16 + lane] = lane == 0 ? s : 0.f; } }
        }
    }
    {
        f32x2* rope = (f32x2*)(a.ws + WS_ROPE);
        for (int e = (F.vcu * NTHR + tid); e < SEQ * 16; e += F.G * NTHR) {
            const int t = e >> 4, i = e & 15;
            double invf = 1.0; for (int q = 0; q < i; ++q) invf *= 0.56234132519034907;
            const double ang = (double)t * invf;
            const double nq = __builtin_rint(ang * 0.63661977236758138);
            double r = __builtin_fma(-nq, 1.5707963267948966, ang); r = __builtin_fma(-nq, 6.123233995736766e-17, r);
            const double r2 = r * r;
            double sp = -1.0 / 6227020800.0; sp = sp * r2 + 1.0 / 39916800.0; sp = sp * r2 - 1.0 / 362880.0; sp = sp * r2 + 1.0 / 5040.0; sp = sp * r2 - 1.0 / 120.0; sp = sp * r2 + 1.0 / 6.0;
            const double sn = r - r * r2 * sp;
            double cp = 1.0 / 87178291200.0; cp = cp * r2 - 1.0 / 479001600.0; cp = cp * r2 + 1.0 / 3628800.0; cp = cp * r2 - 1.0 / 40320.0; cp = cp * r2 + 1.0 / 720.0; cp = cp * r2 - 1.0 / 24.0; cp = cp * r2 + 0.5;
            const double cs = 1.0 - r2 * cp;
            const int qd = ((int)nq) & 3;
            const double s_out = qd == 0 ? sn : qd == 1 ? cs : qd == 2 ? -sn : -cs;
            const double c_out = qd == 0 ? cs : qd == 1 ? -sn : qd == 2 ? -cs : sn;
            rope[e] = (f32x2){(float)c_out, (float)s_out};
        }
    }
}

struct MixCtx { bf16* proj; int l; const Args* a; bf16* yb; int ldy; };

__device__ __forceinline__ void ld8bf(const bf16* p, float (&o)[8]) {
    const v4u u = *(const GAS v4u*)p;
    o[0] = bflo(u.x); o[1] = bfhi(u.x); o[2] = bflo(u.y); o[3] = bfhi(u.y); o[4] = bflo(u.z); o[5] = bfhi(u.z); o[6] = bflo(u.w); o[7] = bfhi(u.w);
}
__device__ __forceinline__ void st8f(LAS float* p, const float (&v)[8]) { *(LAS f32x4*)p = (f32x4){v[0], v[1], v[2], v[3]}; *(LAS f32x4*)(p + 4) = (f32x4){v[4], v[5], v[6], v[7]}; }
__device__ __forceinline__ void ld8f(const LAS float* p, float (&v)[8]) { const f32x4 a = *(const LAS f32x4*)p, b = *(const LAS f32x4*)(p + 4); v[0] = a.x; v[1] = a.y; v[2] = a.z; v[3] = a.w; v[4] = b.x; v[5] = b.y; v[6] = b.z; v[7] = b.w; }

__device__ __forceinline__ void up8bf(const v4u& u, float (&o)[8]) { o[0] = bflo(u.x); o[1] = bfhi(u.x); o[2] = bflo(u.y); o[3] = bfhi(u.y); o[4] = bflo(u.z); o[5] = bfhi(u.z); o[6] = bflo(u.w); o[7] = bfhi(u.w); }
template <int GATE>
__device__ __forceinline__ void scan_epilogue(const LAS float* obuf, const v4u& gu, bf16* yb, int ldy, size_t row, int ycol, const float* ng, int t, int c) {
    float o[8]; ld8f(obuf + t * 64 + 8 * c, o);
    float ss = 0.f;
#pragma unroll
    for (int e = 0; e < 8; ++e) ss += o[e] * o[e];
    ss = red8(ss);
    const float rstd = __builtin_amdgcn_rsqf(ss * (1.f / 64.f) + EPS);
    float g[8]; up8bf(gu, g);
    float y[8];
#pragma unroll
    for (int e = 0; e < 8; ++e) y[e] = o[e] * rstd * ng[8 * c + e] * (GATE == 0 ? fsigmoid(g[e]) : fsilu(g[e]));
    v4u w; w.x = pk2(y[0], y[1]); w.y = pk2(y[2], y[3]); w.z = pk2(y[4], y[5]); w.w = pk2(y[6], y[7]);
    *(GAS v4u*)(yb + row * ldy + ycol + 8 * c) = w;
}
template <int GATE>
__device__ __forceinline__ void scan_epilogue_r(const LAS float* obuf, const v4u& gu, bf16* yb, int ldy, size_t row, int ycol, const float (&ngv)[8], int t, int c) {
    float o[8]; ld8f(obuf + t * 64 + 8 * c, o);
    float ss = 0.f;
#pragma unroll
    for (int e = 0; e < 8; ++e) ss += o[e] * o[e];
    ss = red8(ss);
    const float rstd = __builtin_amdgcn_rsqf(ss * (1.f / 64.f) + EPS);
    float g[8]; up8bf(gu, g);
    float y[8];
#pragma unroll
    for (int e = 0; e < 8; ++e) y[e] = o[e] * rstd * ngv[e] * (GATE == 0 ? fsigmoid(g[e]) : fsilu(g[e]));
    v4u w; w.x = pk2(y[0], y[1]); w.y = pk2(y[2], y[3]); w.z = pk2(y[4], y[5]); w.w = pk2(y[6], y[7]);
    *(GAS v4u*)(yb + row * ldy + ycol + 8 * c) = w;
}
struct F8 { f32x2 a, b, c, d; };
__device__ __forceinline__ F8 ldF8(const LAS float* p) { const f32x4 x = *(const LAS f32x4*)p, y = *(const LAS f32x4*)(p + 4); F8 r; r.a = (f32x2){x.x, x.y}; r.b = (f32x2){x.z, x.w}; r.c = (f32x2){y.x, y.y}; r.d = (f32x2){y.z, y.w}; return r; }
__device__ __forceinline__ float dotF8(const F8& k, const F8& s) { f32x2 p = k.a * s.a; p = k.b * s.b + p; p = k.c * s.c + p; p = k.d * s.d + p; return p.x + p.y; }
__device__ __forceinline__ float dot8(const float (&a)[8], const float (&b)[8]) { return ((a[0] * b[0] + a[1] * b[1]) + (a[2] * b[2] + a[3] * b[3])) + ((a[4] * b[4] + a[5] * b[5]) + (a[6] * b[6] + a[7] * b[7])); }

__device__ __forceinline__ void scan_hgrn2(Frame& F, const MixCtx& X, int b, int h) {
    OPAQUE_TID();
    LAS float* qs = (LAS float*)(F.lds + RING_OFF); LAS float* fs = qs + 4096; LAS float* is = fs + 4096; LAS float* obuf = is + 4096;
    const int t = tid >> 3, c = tid & 7, vl = lane >> 3, kg = lane & 7, v = 8 * wave + vl;
    float lb[8];
    { const float* lg = X.a->in[I_LB];
#pragma unroll
      for (int e = 0; e < 8; ++e) { const int ch = h * 64 + 8 * c + e; const float x0 = lg[ch], x1 = lg[256 + ch], x2 = lg[512 + ch], x3 = lg[768 + ch];
          const float mx = fmaxf(fmaxf(x0, x1), fmaxf(x2, x3)); const float e0 = fexp(x0 - mx), e1 = fexp(x1 - mx), e2 = fexp(x2 - mx), e3 = fexp(x3 - mx);
          const float inv = 1.f / (e0 + e1 + e2 + e3); const float c1 = e1 * inv, c2 = c1 + e2 * inv, c3 = c2 + e3 * inv;
          lb[e] = X.l == 0 ? 0.f : X.l == 1 ? c1 : X.l == 2 ? c2 : c3; } }
    const float* ng = X.a->in[I_HGN] + X.l * 256 + h * 64;
    F8 S; S.a = S.b = S.c = S.d = (f32x2){0.f, 0.f};
    const bf16* base = X.proj + ((size_t)b * SEQ + t) * NMIX + h * 64 + 8 * c;
    v4u rq = *(const GAS v4u*)(base + C_AQ), rf = *(const GAS v4u*)(base + C_AF), ri = *(const GAS v4u*)(base + C_AI), rg = *(const GAS v4u*)(base + C_AG);
    for (int n = 0; n < NCHUNK; ++n) {
        const size_t row = (size_t)b * SEQ + n * CHUNK + t;
        { float q[8], f[8], iv[8]; up8bf(rq, q); up8bf(rf, f); up8bf(ri, iv);
#pragma unroll
          for (int e = 0; e < 8; ++e) { q[e] = fsilu(q[e]); f[e] = lb[e] + (1.f - lb[e]) * fsigmoid(f[e]); iv[e] = fsilu(iv[e]); }
          st8f(qs + t * 64 + 8 * c, q); st8f(fs + t * 64 + 8 * c, f); st8f(is + t * 64 + 8 * c, iv); }
        const v4u gcur = rg;
        LDS_BARRIER();
        if (n + 1 < NCHUNK) { const bf16* nb = base + (size_t)(n + 1) * CHUNK * NMIX;
            rq = *(const GAS v4u*)(nb + C_AQ); rf = *(const GAS v4u*)(nb + C_AF); ri = *(const GAS v4u*)(nb + C_AI); rg = *(const GAS v4u*)(nb + C_AG); }
        F8 f8 = ldF8(fs + 8 * kg), q8 = ldF8(qs + 8 * kg); float iv = is[v];
#pragma unroll 8
        for (int s = 0; s < CHUNK; ++s) {
            const int sn = (s + 1) & (CHUNK - 1);
            const F8 f8n = ldF8(fs + sn * 64 + 8 * kg), q8n = ldF8(qs + sn * 64 + 8 * kg); const float ivn = is[sn * 64 + v];
            const f32x2 iv2 = {iv, iv};
            S.a = f8.a * (S.a - iv2) + iv2; S.b = f8.b * (S.b - iv2) + iv2; S.c = f8.c * (S.c - iv2) + iv2; S.d = f8.d * (S.d - iv2) + iv2;
            const float po = red8(dotF8(q8, S));
            obuf[s * 64 + v] = po;
            f8 = f8n; q8 = q8n; iv = ivn;
        }
        LDS_BARRIER();
        scan_epilogue<0>(obuf, gcur, X.yb, X.ldy, row, Y_A + h * 64, ng, t, c);
    }
    __syncthreads();
}

__device__ __forceinline__ void scan_retention(Frame& F, const MixCtx& X, int b, int h) {
    OPAQUE_TID();
    LAS float* qs = (LAS float*)(F.lds + RING_OFF); LAS float* ks = qs + 2048; LAS float* vs = ks + 2048; LAS float* obuf = vs + 4096;
    const int t = tid >> 3, c = tid & 7, vl = lane >> 3, kg = lane & 7, v = 8 * wave + vl;
    const float gamma = 1.f - __builtin_amdgcn_exp2f(-5.f - (float)h);
    const float* ng = X.a->in[I_RETN] + X.l * 256 + h * 64;
    const f32x2* rope = (const f32x2*)(X.a->ws + WS_ROPE);
    float S[4] = {0.f, 0.f, 0.f, 0.f};
    const bf16* base = X.proj + ((size_t)b * SEQ + t) * NMIX + h * 64 + 8 * c;
    v4u rx = *(const GAS v4u*)(base + C_DQK), rv = *(const GAS v4u*)(base + C_DV), rg = *(const GAS v4u*)(base + C_DG);
    const int i0 = 8 * (c & 1); const bool hi = (c & 2) != 0; const float sc = c >= 4 ? 0.17677669529663687f : 1.f;
    for (int n = 0; n < NCHUNK; ++n) {
        const int tpos = n * CHUNK + t; const size_t row = (size_t)b * SEQ + tpos;
        {
          float x[8], p[8]; up8bf(rx, x);
#pragma unroll
          for (int e = 0; e < 8; ++e) p[e] = __shfl_xor(x[e], 2);
          float o[8];
#pragma unroll
          for (int e = 0; e < 8; ++e) { const f32x2 cs = rope[tpos * 16 + i0 + e];
              o[e] = (hi ? (p[e] * cs.y + x[e] * cs.x) : (x[e] * cs.x - p[e] * cs.y)) * sc; }
          LAS float* dst = (c < 4 ? qs : ks) + t * 32 + 8 * (c & 3); st8f(dst, o);
          float vv[8]; up8bf(rv, vv); st8f(vs + t * 64 + 8 * c, vv); }
        const v4u gcur = rg;
        LDS_BARRIER();
        if (n + 1 < NCHUNK) { const bf16* nb = base + (size_t)(n + 1) * CHUNK * NMIX; rx = *(const GAS v4u*)(nb + C_DQK); rv = *(const GAS v4u*)(nb + C_DV); rg = *(const GAS v4u*)(nb + C_DG); }
        f32x4 k4 = *(const LAS f32x4*)(ks + 4 * kg), q4 = *(const LAS f32x4*)(qs + 4 * kg); float vv = vs[v];
#pragma unroll 8
        for (int s = 0; s < CHUNK; ++s) {
            const int sn = (s + 1) & (CHUNK - 1);
            const f32x4 k4n = *(const LAS f32x4*)(ks + sn * 32 + 4 * kg), q4n = *(const LAS f32x4*)(qs + sn * 32 + 4 * kg); const float vvn = vs[sn * 64 + v];
            S[0] = gamma * S[0] + k4.x * vv; S[1] = gamma * S[1] + k4.y * vv; S[2] = gamma * S[2] + k4.z * vv; S[3] = gamma * S[3] + k4.w * vv;
            const float po = red8((q4.x * S[0] + q4.y * S[1]) + (q4.z * S[2] + q4.w * S[3]));
            obuf[s * 64 + v] = po;
            k4 = k4n; q4 = q4n; vv = vvn;
        }
        LDS_BARRIER();
        scan_epilogue<1>(obuf, gcur, X.yb, X.ldy, row, Y_D + h * 64, ng, t, c);
    }
    __syncthreads();
}

__device__ __forceinline__ void scan_gdn(Frame& F, const MixCtx& X, int b, int h) {
    OPAQUE_TID();
    LAS float* qs = (LAS float*)(F.lds + RING_OFF); LAS float* ks = qs + 4096; LAS float* vs = ks + 4096; LAS float* obuf = vs + 4096;
    LAS float* ab = obuf + 4096;
    LAS float* cw = ab + 128;
    LAS bf16* raw = (LAS bf16*)(cw + 768);
    const int t = tid >> 3, c = tid & 7, vl = lane >> 3, kg = lane & 7, v = 8 * wave + vl;
    const float* ng = X.a->in[I_GDN] + X.l * 256 + h * 64;
    const float a_exp = fexp(X.a->in[I_ALOG][X.l * 4 + h]), dtb = X.a->in[I_DTB][X.l * 4 + h];
    { const float* w = X.a->in[I_CONV] + (size_t)X.l * 4 * 768;
      for (int i = tid; i < 768; i += NTHR) { const int g = i >> 8, j = (i >> 6) & 3, ch = i & 63; cw[i] = w[j * 768 + g * 256 + h * 64 + ch]; }
      for (int i = tid; i < 3 * 3 * 64; i += NTHR) { const int g = i / 192, r = (i % 192) >> 6, ch = i & 63; raw[(g * 67 + r) * 64 + ch] = 0; } }
    F8 S; S.a = S.b = S.c = S.d = (f32x2){0.f, 0.f};
    const bf16* base = X.proj + ((size_t)b * SEQ + t) * NMIX + h * 64 + 8 * c;
    const bf16* abase = X.proj + ((size_t)b * SEQ + (tid & 63)) * NMIX + h;
    v4u rq = *(const GAS v4u*)(base + C_BQ), rk = *(const GAS v4u*)(base + C_BK), rv = *(const GAS v4u*)(base + C_BV), rg = *(const GAS v4u*)(base + C_BG);
    unsigned ra = 0, rb = 0; if (tid < 64) { ra = abase[C_BA]; rb = abase[C_BB]; }
    __syncthreads();
    for (int n = 0; n < NCHUNK; ++n) {
        const size_t row = (size_t)b * SEQ + n * CHUNK + t;
        *(LAS v4u*)(raw + (0 * 67 + 3 + t) * 64 + 8 * c) = rq; *(LAS v4u*)(raw + (1 * 67 + 3 + t) * 64 + 8 * c) = rk; *(LAS v4u*)(raw + (2 * 67 + 3 + t) * 64 + 8 * c) = rv;
        if (tid < 64) { const float z = bflo(ra) + dtb; const float sp = fmaxf(z, 0.f) + __builtin_amdgcn_logf(1.f + fexp(-fabsf(z))) * 0.6931471805599453f;
            ab[2 * tid] = fexp(-a_exp * sp); ab[2 * tid + 1] = fsigmoid(bflo(rb)); }
        const v4u gcur = rg;
        LDS_BARRIER();
        if (n + 1 < NCHUNK) { const bf16* nb = base + (size_t)(n + 1) * CHUNK * NMIX;
            rq = *(const GAS v4u*)(nb + C_BQ); rk = *(const GAS v4u*)(nb + C_BK); rv = *(const GAS v4u*)(nb + C_BV); rg = *(const GAS v4u*)(nb + C_BG);
            if (tid < 64) { const bf16* na = abase + (size_t)(n + 1) * CHUNK * NMIX; ra = na[C_BA]; rb = na[C_BB]; } }
        {
          float y[3][8];
#pragma unroll
          for (int g = 0; g < 3; ++g) {
#pragma unroll
              for (int e = 0; e < 8; ++e) y[g][e] = 0.f;
#pragma unroll
              for (int j = 0; j < 4; ++j) { const v4u u = *(const LAS v4u*)(raw + (g * 67 + t + j) * 64 + 8 * c); float w8[8]; ld8f(cw + (g * 4 + j) * 64 + 8 * c, w8);
                  y[g][0] += bflo(u.x) * w8[0]; y[g][1] += bfhi(u.x) * w8[1]; y[g][2] += bflo(u.y) * w8[2]; y[g][3] += bfhi(u.y) * w8[3];
                  y[g][4] += bflo(u.z) * w8[4]; y[g][5] += bfhi(u.z) * w8[5]; y[g][6] += bflo(u.w) * w8[6]; y[g][7] += bfhi(u.w) * w8[7]; }
#pragma unroll
              for (int e = 0; e < 8; ++e) y[g][e] = fsilu(y[g][e]); }
          float sq = 0.f, sk = 0.f;
#pragma unroll
          for (int e = 0; e < 8; ++e) { sq += y[0][e] * y[0][e]; sk += y[1][e] * y[1][e]; }
          sq = red8(sq); sk = red8(sk);
          const float rq_ = __builtin_amdgcn_rsqf(sq + EPS) * 0.125f, rk_ = __builtin_amdgcn_rsqf(sk + EPS);
#pragma unroll
          for (int e = 0; e < 8; ++e) { y[0][e] *= rq_; y[1][e] *= rk_; }
          st8f(qs + t * 64 + 8 * c, y[0]); st8f(ks + t * 64 + 8 * c, y[1]); st8f(vs + t * 64 + 8 * c, y[2]); }
        LDS_BARRIER();
        if (tid < 3 * 3 * 8) { const int g = tid / 24, r = (tid % 24) >> 3, cc = tid & 7;
            *(LAS v4u*)(raw + (g * 67 + r) * 64 + 8 * cc) = *(const LAS v4u*)(raw + (g * 67 + 64 + r) * 64 + 8 * cc); }
        F8 k8 = ldF8(ks + 8 * kg), q8 = ldF8(qs + 8 * kg); float vv = vs[v]; f32x2 abv = *(const LAS f32x2*)ab;
#pragma unroll 8
        for (int s = 0; s < CHUNK; ++s) {
            const int sn = (s + 1) & (CHUNK - 1);
            const F8 k8n = ldF8(ks + sn * 64 + 8 * kg), q8n = ldF8(qs + sn * 64 + 8 * kg); const float vvn = vs[sn * 64 + v]; const f32x2 abn = *(const LAS f32x2*)(ab + 2 * sn);
            const float pk = red8(dotF8(k8, S));
            const float d = abv.y * (vv - abv.x * pk);
            const f32x2 d2 = {d, d}, al2 = {abv.x, abv.x};
            S.a = al2 * S.a + k8.a * d2; S.b = al2 * S.b + k8.b * d2; S.c = al2 * S.c + k8.c * d2; S.d = al2 * S.d + k8.d * d2;
            const float po = red8(dotF8(q8, S));
            obuf[s * 64 + v] = po;
            k8 = k8n; q8 = q8n; vv = vvn; abv = abn;
        }
        LDS_BARRIER();
        scan_epilogue<1>(obuf, gcur, X.yb, X.ldy, row, Y_B + h * 64, ng, t, c);
    }
    __syncthreads();
}

typedef float f32x16 __attribute__((ext_vector_type(16)));
typedef short bf16x8 __attribute__((ext_vector_type(8)));
typedef short s16x4 __attribute__((ext_vector_type(4)));
__device__ __forceinline__ unsigned cvtpk(float lo, float hi) { return pk2(lo, hi); }
__device__ __forceinline__ void swap32(float& a, float& b) { asm volatile("s_nop 1\n\tv_permlane32_swap_b32 %0, %1\n\ts_nop 1" : "+v"(a), "+v"(b)); }
constexpr int SB_KBUF = 8192, SB_VROW = 144, SB_VBUF = 64 * SB_VROW, SB_STAGE = SB_KBUF + SB_VBUF;
__device__ __forceinline__ int sb_voff(int d, int key) { return d * SB_VROW + ((((key >> 3) ^ (d >> 3)) & 7) << 4) + (key & 7) * 2; }
constexpr float SB_C2 = 0.125f * 1.4426950408889634f;
__device__ __forceinline__ void sb_write_tile(LAS unsigned char* buf, const v4u& kr, const v4u& vr, int skey, int sc) {
    *(LAS v4u*)(buf + skey * 128 + ((sc ^ ((skey >> 1) & 7)) << 4)) = kr;
    LAS unsigned char* vt = buf + SB_KBUF;
    *(LAS unsigned short*)(vt + sb_voff(8 * sc + 0, skey)) = (unsigned short)vr.x; *(LAS unsigned short*)(vt + sb_voff(8 * sc + 1, skey)) = (unsigned short)(vr.x >> 16);
    *(LAS unsigned short*)(vt + sb_voff(8 * sc + 2, skey)) = (unsigned short)vr.y; *(LAS unsigned short*)(vt + sb_voff(8 * sc + 3, skey)) = (unsigned short)(vr.y >> 16);
    *(LAS unsigned short*)(vt + sb_voff(8 * sc + 4, skey)) = (unsigned short)vr.z; *(LAS unsigned short*)(vt + sb_voff(8 * sc + 5, skey)) = (unsigned short)(vr.z >> 16);
    *(LAS unsigned short*)(vt + sb_voff(8 * sc + 6, skey)) = (unsigned short)vr.w; *(LAS unsigned short*)(vt + sb_voff(8 * sc + 7, skey)) = (unsigned short)(vr.w >> 16);
}
__device__ __forceinline__ void sb_unit(Frame& F, const MixCtx& X, int b, int h, int qb) {
    OPAQUE_TID();
    LAS unsigned char* L = F.lds + RING_OFF;
    const int ql = lane & 31, hh = lane >> 5;
    const size_t rowq = (size_t)b * SEQ + 256 * qb + 32 * wave + ql;
    bf16x8 qf[4];
#pragma unroll
    for (int s = 0; s < 4; ++s) { const v4u u = *(const GAS v4u*)(X.proj + rowq * NMIX + C_CQ + h * 64 + 16 * s + 8 * hh);
        v4u w; w.x = cvtpk(bflo(u.x) * SB_C2, bfhi(u.x) * SB_C2); w.y = cvtpk(bflo(u.y) * SB_C2, bfhi(u.y) * SB_C2); w.z = cvtpk(bflo(u.z) * SB_C2, bfhi(u.z) * SB_C2); w.w = cvtpk(bflo(u.w) * SB_C2, bfhi(u.w) * SB_C2);
        qf[s] = __builtin_bit_cast(bf16x8, w); }
    f32x16 O0, O1;
#pragma unroll
    for (int i = 0; i < 16; ++i) { O0[i] = 0.f; O1[i] = 0.f; }
    float carry = 1.f;
    const int Tmax = 4 * qb + 3, wblk = 8 * qb + wave;
    const int skey = tid >> 3, sc = tid & 7;
    const bf16* kg = X.proj + (size_t)b * SEQ * NMIX + C_CK + h * 64 + 8 * sc;
    const bf16* vg = X.proj + (size_t)b * SEQ * NMIX + C_CV + h * 64 + 8 * sc;
    v4u kr = *(const GAS v4u*)(kg + (size_t)(64 * Tmax + skey) * NMIX), vr = *(const GAS v4u*)(vg + (size_t)(64 * Tmax + skey) * NMIX);
    sb_write_tile(L + (Tmax & 1) * SB_STAGE, kr, vr, skey, sc);
    LAS int* dflag = (LAS int*)(L + 2 * SB_STAGE);
    if (tid < 16) dflag[tid] = 0;
    for (int T = Tmax; T >= 0; --T) {
        __syncthreads();
        if (T < Tmax) { const LAS int* df = dflag + ((T + 1) & 1) * 8; if ((df[0] & df[1] & df[2] & df[3] & df[4] & df[5] & df[6] & df[7]) != 0) break; }
        if (T > 0) { kr = *(const GAS v4u*)(kg + (size_t)(64 * (T - 1) + skey) * NMIX); vr = *(const GAS v4u*)(vg + (size_t)(64 * (T - 1) + skey) * NMIX); }
        const LAS unsigned char* Kb = L + (T & 1) * SB_STAGE; const LAS unsigned char* Vb = Kb + SB_KBUF;
#pragma unroll
        for (int kb2 = 1; kb2 >= 0; --kb2) {
            const int blk = 2 * T + kb2;
            if (blk <= wblk) {
                f32x16 S;
#pragma unroll
                for (int i = 0; i < 16; ++i) S[i] = 0.f;
                const int key = 32 * kb2 + ql;
#pragma unroll
                for (int s = 0; s < 4; ++s) { const bf16x8 kf = *(const LAS bf16x8*)(Kb + key * 128 + (((2 * s + hh) ^ ((key >> 1) & 7)) << 4));
                    S = __builtin_amdgcn_mfma_f32_32x32x16_bf16(kf, qf[s], S, 0, 0, 0); }
                float r[16];
                const bool diag = (blk == wblk);
#pragma unroll
                for (int i = 0; i < 16; ++i) { const float e = __builtin_amdgcn_exp2f(S[i]); float ri = __builtin_amdgcn_rcpf(1.f + e);
                    if (diag) { const int kappa = (i & 3) + 8 * (i >> 2) + 4 * hh; ri = kappa < ql ? ri : 1.f; }
                    r[i] = ri; }
                float Hg[4], pt[4];
                { float G[4];
#pragma unroll
                  for (int g = 0; g < 4; ++g) { const float tot = (r[4 * g] * r[4 * g + 1]) * (r[4 * g + 2] * r[4 * g + 3]);
                      float t0 = tot, t1 = tot; swap32(t0, t1);
                      G[g] = t0 * t1; pt[g] = hh ? 1.f : t1; }
                  Hg[3] = carry; Hg[2] = Hg[3] * G[3]; Hg[1] = Hg[2] * G[2]; Hg[0] = Hg[1] * G[1]; carry = Hg[0] * G[0]; }
                float w[16];
#pragma unroll
                for (int g = 0; g < 4; ++g) { float run = Hg[g] * pt[g];
#pragma unroll
                    for (int i = 3; i >= 0; --i) { const float nr = run * r[4 * g + i]; w[4 * g + i] = run - nr; run = nr; } }
#pragma unroll
                for (int sp = 0; sp < 2; ++sp) {
                    v4u pw; pw.x = cvtpk(w[8 * sp], w[8 * sp + 1]); pw.y = cvtpk(w[8 * sp + 2], w[8 * sp + 3]); pw.z = cvtpk(w[8 * sp + 4], w[8 * sp + 5]); pw.w = cvtpk(w[8 * sp + 6], w[8 * sp + 7]);
                    const bf16x8 pf = __builtin_bit_cast(bf16x8, pw);
#pragma unroll
                    for (int dt = 0; dt < 2; ++dt) {
                        const s16x4 v0 = *(const LAS s16x4*)(Vb + sb_voff(32 * dt + ql, 32 * kb2 + 16 * sp + 4 * hh)), v1 = *(const LAS s16x4*)(Vb + sb_voff(32 * dt + ql, 32 * kb2 + 16 * sp + 8 + 4 * hh));
                        const bf16x8 vf = {v0[0], v0[1], v0[2], v0[3], v1[0], v1[1], v1[2], v1[3]};
                        if (dt == 0) O0 = __builtin_amdgcn_mfma_f32_32x32x16_bf16(vf, pf, O0, 0, 0, 0); else O1 = __builtin_amdgcn_mfma_f32_32x32x16_bf16(vf, pf, O1, 0, 0, 0); }
                }
            }
        }
        if (lane == 0) dflag[(T & 1) * 8 + wave] = (__ballot(carry != 0.f) == 0ull) ? 1 : 0;
        if (T > 0) sb_write_tile(L + ((T - 1) & 1) * SB_STAGE, kr, vr, skey, sc);
    }
    float ss = 0.f;
#pragma unroll
    for (int i = 0; i < 16; ++i) ss += O0[i] * O0[i] + O1[i] * O1[i];
    { float s0 = ss, s1 = ss; swap32(s0, s1); ss = s0 + s1; }
    const float rstd = __builtin_amdgcn_rsqf(ss * (1.f / 64.f) + EPS);
    const float* ng = X.a->in[I_SBN] + X.l * 256 + h * 64;
#pragma unroll
    for (int dt = 0; dt < 2; ++dt)
#pragma unroll
        for (int g = 0; g < 4; ++g) { const int d0 = 32 * dt + 8 * g + 4 * hh; const f32x4 gn = *(const f32x4*)(ng + d0);
            const float y0 = (dt ? O1[4 * g] : O0[4 * g]) * rstd * gn.x, y1 = (dt ? O1[4 * g + 1] : O0[4 * g + 1]) * rstd * gn.y, y2 = (dt ? O1[4 * g + 2] : O0[4 * g + 2]) * rstd * gn.z, y3 = (dt ? O1[4 * g + 3] : O0[4 * g + 3]) * rstd * gn.w;
            *(GAS f32x2*)(X.yb + rowq * X.ldy + Y_C + h * 64 + d0) = __builtin_bit_cast(f32x2, (unsigned long long)pk2(y0, y1) | ((unsigned long long)pk2(y2, y3) << 32)); }
    __syncthreads();
}

constexpr int GT_TR = 144;
constexpr int GO_QI = 0, GO_KI = 8192, GO_QS = 16384, GO_KG = 24576, GO_TT = 32768, GO_KT = 40960, GO_VR = GO_KT + 64 * GT_TR, GO_VT = GO_VR + 64 * GT_TR, GO_ST = GO_VT + 64 * GT_TR,
              GO_VEC = GO_ST + 64 * GT_TR, GO_CW = GO_VEC + 1024, GO_RAW = GO_CW + 3072, GO_END = GO_RAW + 3 * 67 * 128;
static_assert(GO_END <= RING_BYTES && GO_VEC % 16 == 0 && GO_RAW % 16 == 0, "GDN LDS map");
constexpr int GO_KB = GO_QS;
__device__ __forceinline__ bf16x8 frag_rm(const LAS unsigned char* X, int row, int s, int hh) { return *(const LAS bf16x8*)(X + row * 128 + (((2 * s + hh) ^ ((row >> 1) & 7)) << 4)); }
__device__ __forceinline__ int tr_off(int row, int tok) { return row * GT_TR + ((((tok >> 3) ^ (row >> 3)) & 7) << 4) + (tok & 7) * 2; }
__device__ __forceinline__ bf16x8 frag_tr(const LAS unsigned char* Y, int row, int s, int hh) { return *(const LAS bf16x8*)(Y + tr_off(row, 16 * s + 8 * hh)); }
__device__ __forceinline__ bf16x8 frag_tr_perm(const LAS unsigned char* Y, int row, int j0, int hh) {
    const s16x4 a = *(const LAS s16x4*)(Y + tr_off(row, j0 + 4 * hh)), b = *(const LAS s16x4*)(Y + tr_off(row, j0 + 8 + 4 * hh));
    return (bf16x8){a[0], a[1], a[2], a[3], b[0], b[1], b[2], b[3]}; }
__device__ __forceinline__ bf16x8 frag_rm_perm(const LAS unsigned char* X, int row, int j0, int hh) {
    const int sw = (row >> 1) & 7, c0 = j0 >> 3; const LAS unsigned char* r = X + row * 128 + 8 * hh;
    const s16x4 a = *(const LAS s16x4*)(r + ((c0 ^ sw) << 4)), b = *(const LAS s16x4*)(r + (((c0 + 1) ^ sw) << 4));
    return (bf16x8){a[0], a[1], a[2], a[3], b[0], b[1], b[2], b[3]}; }
struct TrLane { int xo[4]; int xh[2]; int o8; };
__device__ __forceinline__ TrLane tr_lane(int ql, int hh) { TrLane T; const int g = ql >> 3;
#pragma unroll
    for (int j = 0; j < 4; ++j) T.xo[j] = (j ^ g) << 4;
    T.xh[0] = (hh ^ g) << 4; T.xh[1] = ((2 + hh) ^ g) << 4; T.o8 = 8 * hh; return T; }
__device__ __forceinline__ bf16x8 frag_tr_x(const LAS unsigned char* Y, const TrLane& T, int row, int s) { return *(const LAS bf16x8*)(Y + row * GT_TR + ((((s >> 1) ^ (row >> 5)) & 1) << 6) + T.xh[s & 1]); }
__device__ __forceinline__ int tr_c4(const TrLane& T, int row, int tchi, int tl) { return row * GT_TR + T.o8 + (((tchi ^ (row >> 5)) & 1) << 6) + T.xo[tl]; }
__device__ __forceinline__ bf16x8 frag_tr_perm_x(const LAS unsigned char* Y, const TrLane& T, int row, int j0) {
    const s16x4 a = *(const LAS s16x4*)(Y + tr_c4(T, row, j0 >> 5, (j0 >> 3) & 3)), b = *(const LAS s16x4*)(Y + tr_c4(T, row, j0 >> 5, ((j0 >> 3) & 3) + 1));
    return (bf16x8){a[0], a[1], a[2], a[3], b[0], b[1], b[2], b[3]}; }
__device__ __forceinline__ bf16x8 pack8(float a0, float a1, float a2, float a3, float a4, float a5, float a6, float a7) {
    v4u w; w.x = cvtpk(a0, a1); w.y = cvtpk(a2, a3); w.z = cvtpk(a4, a5); w.w = cvtpk(a6, a7); return __builtin_bit_cast(bf16x8, w); }
__device__ __forceinline__ unsigned long long pack4(float a0, float a1, float a2, float a3) { return (unsigned long long)cvtpk(a0, a1) | ((unsigned long long)cvtpk(a2, a3) << 32); }
__device__ __forceinline__ v4u pk8bf(const float (&v)[8]) { v4u w; w.x = pk2(v[0], v[1]); w.y = pk2(v[2], v[3]); w.z = pk2(v[4], v[5]); w.w = pk2(v[6], v[7]); return w; }
__device__ __forceinline__ void st_rm(LAS unsigned char* X, int t, int c, const float (&v)[8]) { *(LAS v4u*)(X + t * 128 + ((c ^ ((t >> 1) & 7)) << 4)) = pk8bf(v); }
__device__ __forceinline__ void st_trT(LAS unsigned char* Y, int t, int c, const float (&v)[8]) {
#pragma unroll
    for (int e = 0; e < 8; e += 2) { const unsigned p = pk2(v[e], v[e + 1]);
        *(LAS unsigned short*)(Y + tr_off(8 * c + e, t)) = (unsigned short)p; *(LAS unsigned short*)(Y + tr_off(8 * c + e + 1, t)) = (unsigned short)(p >> 16); } }

__device__ __forceinline__ void gdn_conv(const LAS bf16* raw, const LAS float* cw, int t, int c, float (&y)[3][8]) {
#pragma unroll
    for (int g = 0; g < 3; ++g) {
#pragma unroll
        for (int e = 0; e < 8; ++e) y[g][e] = 0.f;
#pragma unroll
        for (int j = 0; j < 4; ++j) { const v4u u = *(const LAS v4u*)(raw + (g * 67 + t + j) * 64 + 8 * c); float w8[8]; ld8f(cw + (g * 4 + j) * 64 + 8 * c, w8);
            y[g][0] += bflo(u.x) * w8[0]; y[g][1] += bfhi(u.x) * w8[1]; y[g][2] += bflo(u.y) * w8[2]; y[g][3] += bfhi(u.y) * w8[3];
            y[g][4] += bflo(u.z) * w8[4]; y[g][5] += bfhi(u.z) * w8[5]; y[g][6] += bflo(u.w) * w8[6]; y[g][7] += bfhi(u.w) * w8[7]; }
#pragma unroll
        for (int e = 0; e < 8; ++e) y[g][e] = fsilu(y[g][e]); }
    float sq = 0.f, sk = 0.f;
#pragma unroll
    for (int e = 0; e < 8; ++e) { sq += y[0][e] * y[0][e]; sk += y[1][e] * y[1][e]; }
    sq = red8(sq); sk = red8(sk);
    const float rq_ = __builtin_amdgcn_rsqf(sq + EPS) * 0.125f, rk_ = __builtin_amdgcn_rsqf(sk + EPS);
#pragma unroll
    for (int e = 0; e < 8; ++e) { y[0][e] *= rq_; y[1][e] *= rk_; }
}

__device__ __forceinline__ void gdn_prep(Frame& F, const MixCtx& X, int b, int h, int part) {
    constexpr int pass = 0; const int n0 = 8 * part;
    OPAQUE_TID();
    LAS unsigned char* L = F.lds + RING_OFF;
    LAS float* la = (LAS float*)(L + GO_VEC); LAS float* bet = la + 64; LAS float* gcs = la + 128;
    LAS float* cw = (LAS float*)(L + GO_CW); LAS bf16* raw = (LAS bf16*)(L + GO_RAW);
    const int t = tid >> 3, c = tid & 7, ql = lane & 31, hh = lane >> 5;
    const float* ng = X.a->in[I_GDN] + X.l * 256 + h * 64;
    const float a_exp = fexp(X.a->in[I_ALOG][X.l * 4 + h]), dtb = X.a->in[I_DTB][X.l * 4 + h];
    float* scratch = (float*)(X.a->ws + WS_GDN) + (size_t)(b * 4 + h) * (NCHUNK * 4096);
    const bf16* base = X.proj + ((size_t)b * SEQ + n0 * CHUNK + t) * NMIX + h * 64 + 8 * c;
    const float* abrow = (const float*)((const unsigned char*)X.a->out + OUT_ABP) + ((size_t)b * SEQ + n0 * CHUNK + t) * 128 + c * 8 + h;
    const float* sqrow = (const float*)(X.a->ws + WS_SSQ) + ((size_t)b * SEQ + n0 * CHUNK + t) * 16 + c;
    bf16* xbp = (bf16*)X.a->out;

    {
        { const float* w = X.a->in[I_CONV] + (size_t)X.l * 4 * 768;
          for (int i = tid; i < 768; i += NTHR) { const int g = i >> 8, j = (i >> 6) & 3, ch = i & 63; cw[i] = w[j * 768 + g * 256 + h * 64 + ch]; }
          if (tid < 3 * 3 * 8) { const int g = tid / 24, r = (tid % 24) >> 3, cc = tid & 7; v4u hv = {0u, 0u, 0u, 0u};
              if (n0 > 0) hv = *(const GAS v4u*)(X.proj + ((size_t)b * SEQ + n0 * CHUNK - 3 + r) * NMIX + (g == 0 ? C_BQ : g == 1 ? C_BK : C_BV) + h * 64 + 8 * cc);
              *(LAS v4u*)(raw + (g * 67 + r) * 64 + 8 * cc) = hv; }
          if (pass == 1) for (int i = tid; i < 64 * GT_TR / 4; i += NTHR) ((LAS unsigned*)(L + GO_ST))[i] = 0u; }
        v4u rq = *(const GAS v4u*)(base + C_BQ), rk = *(const GAS v4u*)(base + C_BK), rv = *(const GAS v4u*)(base + C_BV);
        float pa0 = abrow[0], pa1 = abrow[64], pb0 = abrow[4], pb1 = abrow[68], ps0 = sqrow[0], ps1 = sqrow[8];
        f32x16 Sacc;
#pragma unroll
        for (int i = 0; i < 16; ++i) Sacc[i] = 0.f;
        __syncthreads();
        for (int n = n0; n < n0 + 8; ++n) {
            *(LAS v4u*)(raw + (0 * 67 + 3 + t) * 64 + 8 * c) = rq; *(LAS v4u*)(raw + (1 * 67 + 3 + t) * 64 + 8 * c) = rk; *(LAS v4u*)(raw + (2 * 67 + 3 + t) * 64 + 8 * c) = rv;
            { const float sa = red8(pa0 + pa1), sb = red8(pb0 + pb1), rs = __builtin_amdgcn_rsqf(red8(ps0 + ps1) * (1.f / DM) + EPS);
              if (c == 0) { const float z = sa * rs + dtb; const float sp = fmaxf(z, 0.f) + __builtin_amdgcn_logf(1.f + fexp(-fabsf(z))) * 0.6931471805599453f;
                  la[t] = -a_exp * sp * 1.4426950408889634f; bet[t] = fsigmoid(sb * rs); } }
            LDS_BARRIER();
            if (n + 1 < n0 + 8) { const bf16* nb = base + (size_t)(n + 1 - n0) * CHUNK * NMIX;
                rq = *(const GAS v4u*)(nb + C_BQ); rk = *(const GAS v4u*)(nb + C_BK); rv = *(const GAS v4u*)(nb + C_BV);
                { const float* na = abrow + (size_t)(n + 1 - n0) * CHUNK * 128; const float* ns = sqrow + (size_t)(n + 1 - n0) * CHUNK * 16;
                  pa0 = na[0]; pa1 = na[64]; pb0 = na[4]; pb1 = na[68]; ps0 = ns[0]; ps1 = ns[8]; } }
            v4u tt = {0u, 0u, 0u, 0u};
            if (pass == 1) tt = *(const GAS v4u*)((const bf16*)(scratch + (size_t)n * 4096) + t * 64 + 8 * c);
            float y[3][8];
            if (pass == 0) { gdn_conv(raw, cw, t, c, y);
                bf16* wb = xbp + ((size_t)b * SEQ + n * CHUNK + t) * DM + h * 64 + 8 * c;
                *(GAS v4u*)(wb + XB_Q) = pk8bf(y[0]); *(GAS v4u*)(wb + XB_K) = pk8bf(y[1]); *(GAS v4u*)(wb + XB_V) = pk8bf(y[2]); }
            else { const v4u u0 = *(const LAS v4u*)(raw + (0 * 67 + 3 + t) * 64 + 8 * c), u1 = *(const LAS v4u*)(raw + (1 * 67 + 3 + t) * 64 + 8 * c), u2 = *(const LAS v4u*)(raw + (2 * 67 + 3 + t) * 64 + 8 * c);
                up8bf(u0, y[0]); up8bf(u1, y[1]); up8bf(u2, y[2]); }
            if (tid < 64) { float x = la[tid];
#pragma unroll
                for (int d = 1; d < 64; d <<= 1) { const float o = __shfl_up(x, d); if (lane >= d) x += o; }
                gcs[tid] = x;
                *(GAS f32x2*)(xbp + ((size_t)b * SEQ + n * CHUNK + tid) * DM + XB_GB + 4 * h) = (f32x2){x, bet[tid]}; }
            LDS_BARRIER();
            if (tid < 3 * 3 * 8) { const int g = tid / 24, r = (tid % 24) >> 3, cc = tid & 7;
                *(LAS v4u*)(raw + (g * 67 + r) * 64 + 8 * cc) = *(const LAS v4u*)(raw + (g * 67 + 64 + r) * 64 + 8 * cc); }
            const float gct = gcs[t], glast = gcs[63], bt = bet[t];
            if (pass == 0) {
                float kb[8];
#pragma unroll
                for (int e = 0; e < 8; ++e) kb[e] = bt * y[1][e];
                st_rm(L + GO_KB, t, c, kb); st_rm(L + GO_KI, t, c, y[1]);
            } else {
                const float eg = fexp(gct), ek = fexp(glast - gct);
                float qs_[8], kg_[8], kt_[8];
#pragma unroll
                for (int e = 0; e < 8; ++e) { qs_[e] = y[0][e] * eg; kg_[e] = y[1][e] * eg; kt_[e] = y[1][e] * ek; }
                st_rm(L + GO_QI, t, c, y[0]); st_rm(L + GO_KI, t, c, y[1]); st_rm(L + GO_QS, t, c, qs_); st_rm(L + GO_KG, t, c, kg_);
                st_trT(L + GO_KT, t, c, kt_); st_trT(L + GO_VR, t, c, y[2]);
                *(LAS v4u*)(L + GO_TT + t * 128 + ((c ^ ((t >> 1) & 7)) << 4)) = tt;
            }
            LDS_BARRIER();
            if (pass == 0) {
                if (wave < 3) {
                    const int ab = wave == 0 ? 0 : 1, bb = wave == 2 ? 1 : 0;
                    f32x16 D;
#pragma unroll
                    for (int i = 0; i < 16; ++i) D[i] = 0.f;
#pragma unroll
                    for (int s = 0; s < 4; ++s) D = __builtin_amdgcn_mfma_f32_32x32x16_bf16(frag_rm(L + GO_KB, 32 * ab + ql, s, hh), frag_rm(L + GO_KI, 32 * bb + ql, s, hh), D, 0, 0, 0);
                    const float gcb = gcs[32 * bb + ql]; bf16* mt = (bf16*)(scratch + (size_t)n * 4096) + (32 * bb + ql) * 64 + 32 * ab;
#pragma unroll
                    for (int g = 0; g < 4; ++g) { const f32x4 ga = *(const LAS f32x4*)(gcs + 32 * ab + 8 * g + 4 * hh); f32x4 o;
#pragma unroll
                        for (int i = 0; i < 4; ++i) { const int a = 32 * ab + 8 * g + 4 * hh + i; o[i] = (a > 32 * bb + ql) ? D[4 * g + i] * __builtin_amdgcn_exp2f(ga[i] - gcb) : 0.f; }
                        *(GAS unsigned long long*)(mt + 8 * g + 4 * hh) = (unsigned long long)pk2(o[0], o[1]) | ((unsigned long long)pk2(o[2], o[3]) << 32); }
                }
            } else {
                if (wave < 4) {
                    const int tb = wave & 1, vb = wave >> 1;
                    f32x16 R0, R1;
#pragma unroll
                    for (int tb2 = 0; tb2 < 2; ++tb2) {
                        f32x16 ks;
#pragma unroll
                        for (int i = 0; i < 16; ++i) ks[i] = 0.f;
#pragma unroll
                        for (int s = 0; s < 4; ++s) ks = __builtin_amdgcn_mfma_f32_32x32x16_bf16(frag_rm(L + GO_KG, 32 * tb2 + ql, s, hh), frag_tr(L + GO_ST, 32 * vb + ql, s, hh), ks, 0, 0, 0);
#pragma unroll
                        for (int g = 0; g < 4; ++g) { const s16x4 vr = *(const LAS s16x4*)(L + GO_VR + tr_off(32 * vb + ql, 32 * tb2 + 8 * g + 4 * hh));
                            const f32x4 be = *(const LAS f32x4*)(bet + 32 * tb2 + 8 * g + 4 * hh);
#pragma unroll
                            for (int i = 0; i < 4; ++i) { const float r = be[i] * (__builtin_bit_cast(float, (unsigned)(unsigned short)vr[i] << 16) - ks[4 * g + i]); if (tb2 == 0) R0[4 * g + i] = r; else R1[4 * g + i] = r; } }
                    }
                    f32x16 vn;
#pragma unroll
                    for (int i = 0; i < 16; ++i) vn[i] = 0.f;
#pragma unroll
                    for (int sp = 0; sp < 2; ++sp) {
                        vn = __builtin_amdgcn_mfma_f32_32x32x16_bf16(frag_rm_perm(L + GO_TT, 32 * tb + ql, 16 * sp, hh), pack8(R0[8 * sp], R0[8 * sp + 1], R0[8 * sp + 2], R0[8 * sp + 3], R0[8 * sp + 4], R0[8 * sp + 5], R0[8 * sp + 6], R0[8 * sp + 7]), vn, 0, 0, 0);
                        vn = __builtin_amdgcn_mfma_f32_32x32x16_bf16(frag_rm_perm(L + GO_TT, 32 * tb + ql, 32 + 16 * sp, hh), pack8(R1[8 * sp], R1[8 * sp + 1], R1[8 * sp + 2], R1[8 * sp + 3], R1[8 * sp + 4], R1[8 * sp + 5], R1[8 * sp + 6], R1[8 * sp + 7]), vn, 0, 0, 0); }
#pragma unroll
                    for (int g = 0; g < 4; ++g) *(LAS unsigned long long*)(L + GO_VT + tr_off(32 * vb + ql, 32 * tb + 8 * g + 4 * hh)) = pack4(vn[4 * g], vn[4 * g + 1], vn[4 * g + 2], vn[4 * g + 3]);
                }
                LDS_BARRIER();
                if (wave < 2) {
                    const int tb = wave; const size_t row = (size_t)b * SEQ + n * CHUNK + 32 * tb + ql;
                    f32x16 O0, O1;
#pragma unroll
                    for (int i = 0; i < 16; ++i) { O0[i] = 0.f; O1[i] = 0.f; }
                    unsigned long long gq[8];
#pragma unroll
                    for (int dt = 0; dt < 2; ++dt)
#pragma unroll
                        for (int g = 0; g < 4; ++g) gq[dt * 4 + g] = *(const GAS unsigned long long*)(X.proj + row * NMIX + C_BG + h * 64 + 32 * dt + 8 * g + 4 * hh);
                    const float gctq = gcs[32 * tb + ql];
#pragma unroll
                    for (int sb = 0; sb < 2; ++sb) {
                        if (sb <= tb) {
                            f32x16 P;
#pragma unroll
                            for (int i = 0; i < 16; ++i) P[i] = 0.f;
#pragma unroll
                            for (int s = 0; s < 4; ++s) P = __builtin_amdgcn_mfma_f32_32x32x16_bf16(frag_rm(L + GO_KI, 32 * sb + ql, s, hh), frag_rm(L + GO_QI, 32 * tb + ql, s, hh), P, 0, 0, 0);
                            float w[16];
#pragma unroll
                            for (int g = 0; g < 4; ++g) { const f32x4 gs = *(const LAS f32x4*)(gcs + 32 * sb + 8 * g + 4 * hh);
#pragma unroll
                                for (int i = 0; i < 4; ++i) { const int sidx = 32 * sb + 8 * g + 4 * hh + i; w[4 * g + i] = (sidx <= 32 * tb + ql) ? P[4 * g + i] * fexp(gctq - gs[i]) : 0.f; } }
#pragma unroll
                            for (int sp = 0; sp < 2; ++sp) { const bf16x8 pf = pack8(w[8 * sp], w[8 * sp + 1], w[8 * sp + 2], w[8 * sp + 3], w[8 * sp + 4], w[8 * sp + 5], w[8 * sp + 6], w[8 * sp + 7]);
                                O0 = __builtin_amdgcn_mfma_f32_32x32x16_bf16(frag_tr_perm(L + GO_VT, ql, 32 * sb + 16 * sp, hh), pf, O0, 0, 0, 0);
                                O1 = __builtin_amdgcn_mfma_f32_32x32x16_bf16(frag_tr_perm(L + GO_VT, 32 + ql, 32 * sb + 16 * sp, hh), pf, O1, 0, 0, 0); }
                        }
                    }
#pragma unroll
                    for (int s = 0; s < 4; ++s) { const bf16x8 qf = frag_rm(L + GO_QS, 32 * tb + ql, s, hh);
                        O0 = __builtin_amdgcn_mfma_f32_32x32x16_bf16(frag_tr(L + GO_ST, ql, s, hh), qf, O0, 0, 0, 0);
                        O1 = __builtin_amdgcn_mfma_f32_32x32x16_bf16(frag_tr(L + GO_ST, 32 + ql, s, hh), qf, O1, 0, 0, 0); }
                    float ss = 0.f;
#pragma unroll
                    for (int i = 0; i < 16; ++i) ss += O0[i] * O0[i] + O1[i] * O1[i];
                    { float s0 = ss, s1 = ss; swap32(s0, s1); ss = s0 + s1; }
                    const float rstd = __builtin_amdgcn_rsqf(ss * (1.f / 64.f) + EPS);
#pragma unroll
                    for (int dt = 0; dt < 2; ++dt)
#pragma unroll
                        for (int g = 0; g < 4; ++g) { const int d0 = 32 * dt + 8 * g + 4 * hh; const f32x4 gn = *(const f32x4*)(ng + d0);
                            const unsigned glo = (unsigned)gq[dt * 4 + g], ghi = (unsigned)(gq[dt * 4 + g] >> 32);
                            const float y0 = (dt ? O1[4 * g] : O0[4 * g]) * rstd * gn.x * fsilu(bflo(glo)), y1 = (dt ? O1[4 * g + 1] : O0[4 * g + 1]) * rstd * gn.y * fsilu(bfhi(glo)),
                                        y2 = (dt ? O1[4 * g + 2] : O0[4 * g + 2]) * rstd * gn.z * fsilu(bflo(ghi)), y3 = (dt ? O1[4 * g + 3] : O0[4 * g + 3]) * rstd * gn.w * fsilu(bfhi(ghi));
                            *(GAS unsigned long long*)(X.yb + row * X.ldy + Y_B + h * 64 + d0) = (unsigned long long)pk2(y0, y1) | ((unsigned long long)pk2(y2, y3) << 32); }
                } else if (wave >= 4) {
                    const int kb = wave & 1, vb = (wave >> 1) & 1; const float el = fexp(gcs[63]);
#pragma unroll
                    for (int i = 0; i < 16; ++i) Sacc[i] *= el;
#pragma unroll
                    for (int s = 0; s < 4; ++s) Sacc = __builtin_amdgcn_mfma_f32_32x32x16_bf16(frag_tr(L + GO_KT, 32 * kb + ql, s, hh), frag_tr(L + GO_VT, 32 * vb + ql, s, hh), Sacc, 0, 0, 0);
                }
                LDS_BARRIER();
                if (wave >= 4) { const int kb = wave & 1, vb = (wave >> 1) & 1;
#pragma unroll
                    for (int g = 0; g < 4; ++g) *(LAS unsigned long long*)(L + GO_ST + tr_off(32 * vb + ql, 32 * kb + 8 * g + 4 * hh)) = pack4(Sacc[4 * g], Sacc[4 * g + 1], Sacc[4 * g + 2], Sacc[4 * g + 3]);
                }
            }
        }
        __syncthreads();
    }
    __syncthreads();
}

typedef short s16x4_t __attribute__((ext_vector_type(4)));
__device__ __forceinline__ s16x4_t pk4bf(float a, float b, float c, float d) { return __builtin_bit_cast(s16x4_t, (unsigned long long)pk2(a, b) | ((unsigned long long)pk2(c, d) << 32)); }
__device__ __forceinline__ void gdn_tpass(Frame& F, const MixCtx& X, int b, int h, int part) {
    OPAQUE_TID();
    LAS unsigned char* L = F.lds + RING_OFF;
    float* scratch = (float*)(X.a->ws + WS_GDN) + (size_t)(b * 4 + h) * (NCHUNK * 4096);
    LAS unsigned short* mT = (LAS unsigned short*)(L + wave * 16384);
    LAS unsigned short* TT = mT + 4096;
    const int n = 8 * part + wave; const float* gm = scratch + (size_t)n * 4096;
#pragma unroll
    for (int i = 0; i < 8; ++i) *(LAS v4u*)(mT + (i * 64 + lane) * 8) = *(const GAS v4u*)((const bf16*)gm + (i * 64 + lane) * 8);
#pragma unroll
    for (int cc = 0; cc < 8; ++cc) *(LAS v4u*)(TT + lane * 64 + 8 * cc) = (v4u){0u, 0u, 0u, 0u};
    const int bi = lane >> 4, r = lane & 15;
    float Dr[16];
#pragma unroll
    for (int cc = 0; cc < 16; ++cc) Dr[cc] = 0.f;
#pragma unroll
    for (int cc = 15; cc >= 0; --cc) {
        int z = 0; asm volatile("" : "+s"(z));
        if (z == 0) {
            const LAS unsigned short* mp = mT + (16 * bi + cc) * 64 + 16 * bi;
            const v4u u0 = *(const LAS v4u*)mp, u1 = *(const LAS v4u*)(mp + 8);
            float mv[16]; mv[0] = bflo(u0.x); mv[1] = bfhi(u0.x); mv[2] = bflo(u0.y); mv[3] = bfhi(u0.y); mv[4] = bflo(u0.z); mv[5] = bfhi(u0.z); mv[6] = bflo(u0.w); mv[7] = bfhi(u0.w);
            mv[8] = bflo(u1.x); mv[9] = bfhi(u1.x); mv[10] = bflo(u1.y); mv[11] = bfhi(u1.y); mv[12] = bflo(u1.z); mv[13] = bfhi(u1.z); mv[14] = bflo(u1.w); mv[15] = bfhi(u1.w);
            float a0 = (r == cc) ? 1.f : 0.f, a1 = 0.f;
#pragma unroll
            for (int j = cc + 1; j < 16; ++j) { if ((j - cc) & 1) a0 -= Dr[j] * mv[j]; else a1 -= Dr[j] * mv[j]; }
            Dr[cc] = a0 + a1;
        }
    }
    { LAS unsigned short* dp = TT + lane * 64 + 16 * bi;
      *(LAS v4u*)dp = (v4u){pk2(Dr[0], Dr[1]), pk2(Dr[2], Dr[3]), pk2(Dr[4], Dr[5]), pk2(Dr[6], Dr[7])};
      *(LAS v4u*)(dp + 8) = (v4u){pk2(Dr[8], Dr[9]), pk2(Dr[10], Dr[11]), pk2(Dr[12], Dr[13]), pk2(Dr[14], Dr[15])}; }
    {
        const int c16 = lane & 15, g = lane >> 4;
        auto ldA_m = [&](const int i, const int k) -> s16x4_t { const LAS unsigned short* p = mT + (16 * k + 4 * g) * 64 + 16 * i + c16;
            return (s16x4_t){(short)p[0], (short)p[64], (short)p[128], (short)p[192]}; };
        auto ldA_D = [&](const int i) -> s16x4_t { return *(const LAS s16x4_t*)(TT + (16 * i + c16) * 64 + 16 * i + 4 * g); };
        auto ldB_D = [&](const int j) -> s16x4_t { const LAS unsigned short* p = TT + (16 * j + 4 * g) * 64 + 16 * j + c16;
            return (s16x4_t){(short)p[0], (short)p[64], (short)p[128], (short)p[192]}; };
        auto mm = [&](const s16x4_t a, const s16x4_t bb, const f32x4 c) -> f32x4 { return __builtin_amdgcn_mfma_f32_16x16x16bf16_1k(a, bb, c, 0, 0, 0); };
        const f32x4 Z = {0.f, 0.f, 0.f, 0.f};
        auto fin = [&](const int i, const int j, const f32x4 S) -> s16x4_t {
            const f32x4 Tn = mm(ldA_D(i), pk4bf(S[0], S[1], S[2], S[3]), Z);
            const s16x4_t Tb = pk4bf(-Tn[0], -Tn[1], -Tn[2], -Tn[3]);
            LAS unsigned short* p = TT + (16 * i + 4 * g) * 64 + 16 * j + c16;
            p[0] = (unsigned short)Tb[0]; p[64] = (unsigned short)Tb[1]; p[128] = (unsigned short)Tb[2]; p[192] = (unsigned short)Tb[3];
            return Tb; };
        const s16x4_t D0b = ldB_D(0), D1b = ldB_D(1), D2b = ldB_D(2);
        const s16x4_t T10 = fin(1, 0, mm(ldA_m(1, 0), D0b, Z));
        const s16x4_t T21 = fin(2, 1, mm(ldA_m(2, 1), D1b, Z));
        (void)fin(3, 2, mm(ldA_m(3, 2), D2b, Z));
        const s16x4_t T20 = fin(2, 0, mm(ldA_m(2, 1), T10, mm(ldA_m(2, 0), D0b, Z)));
        (void)fin(3, 1, mm(ldA_m(3, 2), T21, mm(ldA_m(3, 1), D1b, Z)));
        (void)fin(3, 0, mm(ldA_m(3, 2), T20, mm(ldA_m(3, 1), T10, mm(ldA_m(3, 0), D0b, Z))));
    }
    { bf16* gt = (bf16*)(scratch + (size_t)n * 4096) + lane * 64;
#pragma unroll
      for (int cc = 0; cc < 8; ++cc) *(GAS v4u*)(gt + 8 * cc) = *(const LAS v4u*)(TT + lane * 64 + 8 * cc); }
    __syncthreads();
}

constexpr int P_QI = 0, P_KI = 16384, P_QS = 32768, P_KG = 49152, P_TT = 57344, P_KT = 65536, P_VR = P_KT + 2 * 64 * GT_TR, P_VT = P_VR + 64 * GT_TR, P_ST = P_VT + 64 * GT_TR,
              P_OB = P_ST + 2 * 64 * GT_TR, P_VEC = P_OB + 16384, P_END = P_VEC + 768;
static_assert(P_END <= RING_BYTES && P_OB % 16 == 0 && P_VEC % 16 == 0, "GDN pipelined LDS map");
struct GdnCell { v4u rq, rk, rv, tt; f32x2 gb; float gl; };
__device__ __forceinline__ void gdn_load_cell(GdnCell& C, const bf16* xbp, const float* scratch, int b, int h, int n, int t, int c) {
    const bf16* base = xbp + ((size_t)b * SEQ + n * CHUNK + t) * DM + h * 64 + 8 * c;
    const bf16* gbase = xbp + ((size_t)b * SEQ + n * CHUNK + t) * DM + XB_GB + 4 * h;
    C.rq = *(const GAS v4u*)(base + XB_Q); C.rk = *(const GAS v4u*)(base + XB_K); C.rv = *(const GAS v4u*)(base + XB_V);
    C.gb = *(const GAS f32x2*)gbase; C.gl = (*(const GAS f32x2*)(gbase + (size_t)(63 - t) * DM)).x;
    C.tt = *(const GAS v4u*)((const bf16*)(scratch + (size_t)n * 4096) + t * 64 + 8 * c);
}
__device__ __forceinline__ void gdn_stage_cell(LAS unsigned char* L, int buf, const GdnCell& C, int t, int c) {
    float q[8], k[8], v[8]; up8bf(C.rq, q); up8bf(C.rk, k); up8bf(C.rv, v);
    const float eg = __builtin_amdgcn_exp2f(C.gb.x), ek = __builtin_amdgcn_exp2f(C.gl - C.gb.x);
    float qs_[8], kg_[8], kt_[8];
#pragma unroll
    for (int e = 0; e < 8; ++e) { qs_[e] = q[e] * eg; kg_[e] = k[e] * eg; kt_[e] = k[e] * ek; }
    const int sw = (c ^ ((t >> 1) & 7)) << 4;
    *(LAS v4u*)(L + P_QI + buf * 8192 + t * 128 + sw) = C.rq; *(LAS v4u*)(L + P_KI + buf * 8192 + t * 128 + sw) = C.rk;
    st_rm(L + P_QS + buf * 8192, t, c, qs_); st_rm(L + P_KG, t, c, kg_); st_trT(L + P_KT + buf * 64 * GT_TR, t, c, kt_); st_trT(L + P_VR, t, c, v);
    *(LAS v4u*)(L + P_TT + t * 128 + sw) = C.tt;
    if (c == 0) { LAS float* vec = (LAS float*)(L + P_VEC); vec[t] = C.gb.y; vec[64 + buf * 64 + t] = C.gb.x; }
}
__device__ __forceinline__ void gdn_main(Frame& F, const MixCtx& X, int b, int h) {
    OPAQUE_TID();
    LAS unsigned char* L = F.lds + RING_OFF;
    LAS float* bet = (LAS float*)(L + P_VEC); LAS float* obuf = (LAS float*)(L + P_OB);
    const int ql = lane & 31, hh = lane >> 5;
    const TrLane TL = tr_lane(ql, hh);
    const float* ng = X.a->in[I_GDN] + X.l * 256 + h * 64;
    const float* scratch = (const float*)(X.a->ws + WS_GDN) + (size_t)(b * 4 + h) * (NCHUNK * 4096);
    const bf16* xbp = (const bf16*)X.a->out;
    if (tid == 0) {
        gu32* cnt = F.ctl + CW_GDN + 64 * (64 * X.l + 4 * b + h) + (X.yb == X.proj ? 0 : 32); unsigned sp = 0;
        while (__hip_atomic_load(cnt, RLX_AGENT) < 4u) { __builtin_amdgcn_s_sleep(2); if (++sp > (1u << 22)) { __hip_atomic_store(F.ctl + CW_TMO, 1u, RLX_AGENT); break; } }
        __builtin_amdgcn_fence(__ATOMIC_ACQUIRE, "agent"); asm volatile("s_waitcnt vmcnt(0)" ::: "memory"); }
    __syncthreads();
    for (int i = tid; i < 2 * 64 * GT_TR / 4; i += NTHR) ((LAS unsigned*)(L + P_ST))[i] = 0u;
    const int sid = tid & 255, t0 = sid >> 3, c = sid & 7;
    const bool stager = wave >= 4;
    float ngv[8];
#pragma unroll
    for (int e = 0; e < 8; ++e) ngv[e] = ng[8 * c + e];
    GdnCell C0, C1; v4u g0 = {0u, 0u, 0u, 0u}, g1 = {0u, 0u, 0u, 0u};
    if (stager) {
        GdnCell D0, D1;
        gdn_load_cell(C0, xbp, scratch, b, h, 0, t0, c); gdn_load_cell(C1, xbp, scratch, b, h, 0, t0 + 32, c);
        gdn_load_cell(D0, xbp, scratch, b, h, 1, t0, c); gdn_load_cell(D1, xbp, scratch, b, h, 1, t0 + 32, c);
        gdn_stage_cell(L, 0, C0, t0, c); gdn_stage_cell(L, 0, C1, t0 + 32, c);
        C0 = D0; C1 = D1;
    }
    f32x16 SA, SB;
#pragma unroll
    for (int i = 0; i < 16; ++i) { SA[i] = 0.f; SB[i] = 0.f; }
    __syncthreads();
    for (int n = 0; n < NCHUNK; ++n) {
        const int cur = n & 1, prv = cur ^ 1;
        if (wave < 4) {
            const int tb = wave & 1, vb = wave >> 1;
            f32x16 R0, R1;
#pragma unroll
            for (int tb2 = 0; tb2 < 2; ++tb2) {
                f32x16 ks;
#pragma unroll
                for (int i = 0; i < 16; ++i) ks[i] = 0.f;
#pragma unroll
                for (int s = 0; s < 4; ++s) ks = __builtin_amdgcn_mfma_f32_32x32x16_bf16(frag_rm(L + P_KG, 32 * tb2 + ql, s, hh), frag_tr_x(L + P_ST + prv * 64 * GT_TR, TL, 32 * vb + ql, s), ks, 0, 0, 0);
#pragma unroll
                for (int g = 0; g < 4; ++g) { const s16x4 vr = *(const LAS s16x4*)(L + P_VR + tr_c4(TL, 32 * vb + ql, tb2, g));
                    const f32x4 be = *(const LAS f32x4*)(bet + 32 * tb2 + 8 * g + 4 * hh);
#pragma unroll
                    for (int i = 0; i < 4; ++i) { const float r = be[i] * (__builtin_bit_cast(float, (unsigned)(unsigned short)vr[i] << 16) - ks[4 * g + i]); if (tb2 == 0) R0[4 * g + i] = r; else R1[4 * g + i] = r; } }
            }
            f32x16 vn;
#pragma unroll
            for (int i = 0; i < 16; ++i) vn[i] = 0.f;
#pragma unroll
            for (int sp = 0; sp < 2; ++sp) {
                vn = __builtin_amdgcn_mfma_f32_32x32x16_bf16(frag_rm_perm(L + P_TT, 32 * tb + ql, 16 * sp, hh), pack8(R0[8 * sp], R0[8 * sp + 1], R0[8 * sp + 2], R0[8 * sp + 3], R0[8 * sp + 4], R0[8 * sp + 5], R0[8 * sp + 6], R0[8 * sp + 7]), vn, 0, 0, 0);
                vn = __builtin_amdgcn_mfma_f32_32x32x16_bf16(frag_rm_perm(L + P_TT, 32 * tb + ql, 32 + 16 * sp, hh), pack8(R1[8 * sp], R1[8 * sp + 1], R1[8 * sp + 2], R1[8 * sp + 3], R1[8 * sp + 4], R1[8 * sp + 5], R1[8 * sp + 6], R1[8 * sp + 7]), vn, 0, 0, 0); }
#pragma unroll
            for (int g = 0; g < 4; ++g) *(LAS unsigned long long*)(L + P_VT + tr_c4(TL, 32 * vb + ql, tb, g)) = pack4(vn[4 * g], vn[4 * g + 1], vn[4 * g + 2], vn[4 * g + 3]);
        } else if (n > 0) {
            const size_t rowp = (size_t)b * SEQ + (n - 1) * CHUNK;
            scan_epilogue_r<1>(obuf, g0, X.yb, X.ldy, rowp + t0, Y_B + h * 64, ngv, t0, c);
            scan_epilogue_r<1>(obuf, g1, X.yb, X.ldy, rowp + t0 + 32, Y_B + h * 64, ngv, t0 + 32, c);
        }
        LDS_BARRIER();
        if (wave < 2) {
            const int tb = wave;
            const LAS float* gcs = (const LAS float*)(L + P_VEC) + 64 + cur * 64;
            f32x16 O0, O1;
#pragma unroll
            for (int i = 0; i < 16; ++i) { O0[i] = 0.f; O1[i] = 0.f; }
            const float gctq = gcs[32 * tb + ql];
#pragma unroll
            for (int sb = 0; sb < 2; ++sb) {
                if (sb <= tb) {
                    f32x16 P;
#pragma unroll
                    for (int i = 0; i < 16; ++i) P[i] = 0.f;
#pragma unroll
                    for (int s = 0; s < 4; ++s) P = __builtin_amdgcn_mfma_f32_32x32x16_bf16(frag_rm(L + P_KI + cur * 8192, 32 * sb + ql, s, hh), frag_rm(L + P_QI + cur * 8192, 32 * tb + ql, s, hh), P, 0, 0, 0);
                    float w[16];
#pragma unroll
                    for (int g = 0; g < 4; ++g) { const f32x4 gs = *(const LAS f32x4*)(gcs + 32 * sb + 8 * g + 4 * hh);
#pragma unroll
                        for (int i = 0; i < 4; ++i) { const int sidx = 32 * sb + 8 * g + 4 * hh + i; w[4 * g + i] = (sidx <= 32 * tb + ql) ? P[4 * g + i] * __builtin_amdgcn_exp2f(gctq - gs[i]) : 0.f; } }
#pragma unroll
                    for (int sp = 0; sp < 2; ++sp) { const bf16x8 pf = pack8(w[8 * sp], w[8 * sp + 1], w[8 * sp + 2], w[8 * sp + 3], w[8 * sp + 4], w[8 * sp + 5], w[8 * sp + 6], w[8 * sp + 7]);
                        O0 = __builtin_amdgcn_mfma_f32_32x32x16_bf16(frag_tr_perm_x(L + P_VT, TL, ql, 32 * sb + 16 * sp), pf, O0, 0, 0, 0);
                        O1 = __builtin_amdgcn_mfma_f32_32x32x16_bf16(frag_tr_perm_x(L + P_VT, TL, 32 + ql, 32 * sb + 16 * sp), pf, O1, 0, 0, 0); }
                }
            }
#pragma unroll
            for (int s = 0; s < 4; ++s) { const bf16x8 qf = frag_rm(L + P_QS + cur * 8192, 32 * tb + ql, s, hh);
                O0 = __builtin_amdgcn_mfma_f32_32x32x16_bf16(frag_tr_x(L + P_ST + prv * 64 * GT_TR, TL, ql, s), qf, O0, 0, 0, 0);
                O1 = __builtin_amdgcn_mfma_f32_32x32x16_bf16(frag_tr_x(L + P_ST + prv * 64 * GT_TR, TL, 32 + ql, s), qf, O1, 0, 0, 0); }
#pragma unroll
            for (int g = 0; g < 4; ++g) { LAS float* op = obuf + (32 * tb + ql) * 64 + 8 * g + 4 * hh;
                *(LAS f32x4*)op = (f32x4){O0[4 * g], O0[4 * g + 1], O0[4 * g + 2], O0[4 * g + 3]}; *(LAS f32x4*)(op + 32) = (f32x4){O1[4 * g], O1[4 * g + 1], O1[4 * g + 2], O1[4 * g + 3]}; }
        } else if (wave < 4) {
            const int kb = wave & 1; const float el = __builtin_amdgcn_exp2f(((const LAS float*)(L + P_VEC))[64 + cur * 64 + 63]);
            const LAS unsigned char* KT = L + P_KT + cur * 64 * GT_TR;
#pragma unroll
            for (int i = 0; i < 16; ++i) { SA[i] *= el; SB[i] *= el; }
#pragma unroll
            for (int s = 0; s < 4; ++s) { const bf16x8 kf = frag_tr_x(KT, TL, 32 * kb + ql, s);
                SA = __builtin_amdgcn_mfma_f32_32x32x16_bf16(kf, frag_tr_x(L + P_VT, TL, ql, s), SA, 0, 0, 0);
                SB = __builtin_amdgcn_mfma_f32_32x32x16_bf16(kf, frag_tr_x(L + P_VT, TL, 32 + ql, s), SB, 0, 0, 0); }
            LAS unsigned char* ST = L + P_ST + cur * 64 * GT_TR;
#pragma unroll
            for (int g = 0; g < 4; ++g) { *(LAS unsigned long long*)(ST + tr_c4(TL, ql, kb, g)) = pack4(SA[4 * g], SA[4 * g + 1], SA[4 * g + 2], SA[4 * g + 3]);
                *(LAS unsigned long long*)(ST + tr_c4(TL, 32 + ql, kb, g)) = pack4(SB[4 * g], SB[4 * g + 1], SB[4 * g + 2], SB[4 * g + 3]); }
        } else {
            const bf16* gt = X.proj + ((size_t)b * SEQ + n * CHUNK + t0) * NMIX + C_BG + h * 64 + 8 * c;
            g0 = *(const GAS v4u*)gt; g1 = *(const GAS v4u*)(gt + (size_t)32 * NMIX);
            if (n + 1 < NCHUNK) { gdn_stage_cell(L, prv, C0, t0, c); gdn_stage_cell(L, prv, C1, t0 + 32, c);
                if (n + 2 < NCHUNK) { gdn_load_cell(C0, xbp, scratch, b, h, n + 2, t0, c); gdn_load_cell(C1, xbp, scratch, b, h, n + 2, t0 + 32, c); } }
        }
        LDS_BARRIER();
    }
    if (wave >= 4) {
        const size_t rowp = (size_t)b * SEQ + (NCHUNK - 1) * CHUNK;
        scan_epilogue_r<1>(obuf, g0, X.yb, X.ldy, rowp + t0, Y_B + h * 64, ngv, t0, c);
        scan_epilogue_r<1>(obuf, g1, X.yb, X.ldy, rowp + t0 + 32, Y_B + h * 64, ngv, t0 + 32, c);
    }
    __syncthreads();
}
__device__ __forceinline__ void gdn_prep_unit(Frame& F, const MixCtx& X, int b, int h, int part) {
    gdn_prep(F, X, b, h, part);
    gdn_tpass(F, X, b, h, part);
    asm volatile("s_waitcnt vmcnt(0)" ::: "memory");
    __syncthreads();
    if (threadIdx.x == 0) { __builtin_amdgcn_fence(__ATOMIC_RELEASE, "agent"); asm volatile("s_waitcnt vmcnt(0)" ::: "memory");
        __hip_atomic_fetch_add(F.ctl + CW_GDN + 64 * (64 * X.l + 4 * b + h), 1u, RLX_AGENT); }
}

constexpr int HO_QI = 0, HO_KI = 8192, HO_QS = 16384, HO_KT = 24576, HO_VT = HO_KT + 64 * GT_TR, HO_ST = HO_VT + 64 * GT_TR, HO_LF = HO_ST + 64 * GT_TR, HO_OB = HO_LF + 16384, HO_SEG = HO_OB + 16384, HO_DD = HO_SEG + 2048, HO_END = HO_DD + 256;
static_assert(HO_END <= RING_BYTES && HO_LF % 16 == 0, "HGRN2 LDS map");
__device__ __forceinline__ void hgrn_unit(Frame& F, const MixCtx& X, int b, int h) {
    OPAQUE_TID();
    LAS unsigned char* L = F.lds + RING_OFF;
    LAS float* LF = (LAS float*)(L + HO_LF); LAS float* obuf = (LAS float*)(L + HO_OB); LAS float* seg = (LAS float*)(L + HO_SEG); LAS float* dd = (LAS float*)(L + HO_DD);
    const int t = tid >> 3, c = tid & 7, ql = lane & 31, hh = lane >> 5;
    const TrLane TL = tr_lane(ql, hh);
    float lb[8];
    { const float* lg = X.a->in[I_LB];
#pragma unroll
      for (int e = 0; e < 8; ++e) { const int ch = h * 64 + 8 * c + e; const float x0 = lg[ch], x1 = lg[256 + ch], x2 = lg[512 + ch], x3 = lg[768 + ch];
          const float mx = fmaxf(fmaxf(x0, x1), fmaxf(x2, x3)); const float e0 = fexp(x0 - mx), e1 = fexp(x1 - mx), e2 = fexp(x2 - mx), e3 = fexp(x3 - mx);
          const float inv = 1.f / (e0 + e1 + e2 + e3); const float c1 = e1 * inv, c2 = c1 + e2 * inv, c3 = c2 + e3 * inv;
          lb[e] = X.l == 0 ? 0.f : X.l == 1 ? c1 : X.l == 2 ? c2 : c3; } }
    const float* ng = X.a->in[I_HGN] + X.l * 256 + h * 64;
    float ngv[8];
#pragma unroll
    for (int e = 0; e < 8; ++e) ngv[e] = ng[8 * c + e];
    for (int i = tid; i < 64 * GT_TR / 4; i += NTHR) ((LAS unsigned*)(L + HO_ST))[i] = 0u;
    f32x16 Sacc;
#pragma unroll
    for (int i = 0; i < 16; ++i) Sacc[i] = 0.f;
    const bf16* base = X.proj + ((size_t)b * SEQ + t) * NMIX + h * 64 + 8 * c;
    v4u rq = *(const GAS v4u*)(base + C_AQ), rf = *(const GAS v4u*)(base + C_AF), ri = *(const GAS v4u*)(base + C_AI), rg = *(const GAS v4u*)(base + C_AG);
    __syncthreads();
    for (int n = 0; n < NCHUNK; ++n) {
        const size_t row = (size_t)b * SEQ + n * CHUNK + t;
        float q[8], kk[8], iv[8], lf[8];
        { float f[8]; up8bf(rq, q); up8bf(rf, f); up8bf(ri, iv);
#pragma unroll
          for (int e = 0; e < 8; ++e) { q[e] = fsilu(q[e]); const float fe = lb[e] + (1.f - lb[e]) * fsigmoid(f[e]); kk[e] = 1.f - fe; lf[e] = __builtin_amdgcn_logf(fe); iv[e] = fsilu(iv[e]); } }
        st8f(LF + t * 64 + 8 * c, lf);
        const v4u gcur = rg;
        LDS_BARRIER();
        if (n + 1 < NCHUNK) { const bf16* nb = base + (size_t)(n + 1) * CHUNK * NMIX;
            rq = *(const GAS v4u*)(nb + C_AQ); rf = *(const GAS v4u*)(nb + C_AF); ri = *(const GAS v4u*)(nb + C_AI); rg = *(const GAS v4u*)(nb + C_AG); }
        { const int k = tid & 63, sg = tid >> 6; float x = 0.f;
#pragma unroll
          for (int j = 0; j < 8; ++j) { x += LF[(8 * sg + j) * 64 + k]; LF[(8 * sg + j) * 64 + k] = x; }
          seg[sg * 64 + k] = x; }
        LDS_BARRIER();
        { float bt[8], r31[8], bl[8];
          {
            f32x2 run[4] = {{0.f, 0.f}, {0.f, 0.f}, {0.f, 0.f}, {0.f, 0.f}}, mine[4] = {{0.f, 0.f}, {0.f, 0.f}, {0.f, 0.f}, {0.f, 0.f}}, p31[4] = {{0.f, 0.f}, {0.f, 0.f}, {0.f, 0.f}, {0.f, 0.f}};
#pragma unroll
            for (int sg = 0; sg < 8; ++sg) {
                const f32x4 a = *(const LAS f32x4*)(seg + sg * 64 + 8 * c), b4 = *(const LAS f32x4*)(seg + sg * 64 + 8 * c + 4);
                if (sg == wave) { asm volatile("" ::: "memory"); mine[0] = run[0]; mine[1] = run[1]; mine[2] = run[2]; mine[3] = run[3]; }
                if (sg == 3) { p31[0] = run[0]; p31[1] = run[1]; p31[2] = run[2]; p31[3] = run[3]; }
                run[0] += (f32x2){a.x, a.y}; run[1] += (f32x2){a.z, a.w}; run[2] += (f32x2){b4.x, b4.y}; run[3] += (f32x2){b4.z, b4.w};
            }
            float l31[8], lt[8]; ld8f(LF + 31 * 64 + 8 * c, l31); ld8f(LF + t * 64 + 8 * c, lt);
#pragma unroll
            for (int e = 0; e < 8; ++e) { bt[e] = lt[e] + mine[e >> 1][e & 1]; r31[e] = l31[e] + p31[e >> 1][e & 1]; bl[e] = run[e >> 1][e & 1]; } }
          float qi[8], ki[8], qs[8], kt[8];
#pragma unroll
          for (int e = 0; e < 8; ++e) { qi[e] = q[e] * __builtin_amdgcn_exp2f(bt[e] - r31[e]); ki[e] = kk[e] * __builtin_amdgcn_exp2f(r31[e] - bt[e]); qs[e] = q[e] * __builtin_amdgcn_exp2f(bt[e]); kt[e] = kk[e] * __builtin_amdgcn_exp2f(bl[e] - bt[e]); }
          st_rm(L + HO_QI, t, c, qi); st_rm(L + HO_KI, t, c, ki); st_rm(L + HO_QS, t, c, qs); st_trT(L + HO_KT, t, c, kt); st_trT(L + HO_VT, t, c, iv);
          if (t == 0) { float de[8];
#pragma unroll
              for (int e = 0; e < 8; ++e) de[e] = __builtin_amdgcn_exp2f(bl[e]);
              st8f(dd + 8 * c, de); } }
        LDS_BARRIER();
        if (wave < 2) {
            const int tb = wave;
            f32x16 O0, O1;
#pragma unroll
            for (int i = 0; i < 16; ++i) { O0[i] = 0.f; O1[i] = 0.f; }
#pragma unroll
            for (int sb = 0; sb < 2; ++sb) {
                if (sb <= tb) {
                    f32x16 P;
#pragma unroll
                    for (int i = 0; i < 16; ++i) P[i] = 0.f;
#pragma unroll
                    for (int s = 0; s < 4; ++s) P = __builtin_amdgcn_mfma_f32_32x32x16_bf16(frag_rm(L + HO_KI, 32 * sb + ql, s, hh), frag_rm(L + HO_QI, 32 * tb + ql, s, hh), P, 0, 0, 0);
                    float w[16];
#pragma unroll
                    for (int i = 0; i < 16; ++i) { const int sidx = 32 * sb + (i & 3) + 8 * (i >> 2) + 4 * hh; w[i] = (sidx <= 32 * tb + ql) ? P[i] : 0.f; }
#pragma unroll
                    for (int sp = 0; sp < 2; ++sp) { const bf16x8 pf = pack8(w[8 * sp], w[8 * sp + 1], w[8 * sp + 2], w[8 * sp + 3], w[8 * sp + 4], w[8 * sp + 5], w[8 * sp + 6], w[8 * sp + 7]);
                        O0 = __builtin_amdgcn_mfma_f32_32x32x16_bf16(frag_tr_perm_x(L + HO_VT, TL, ql, 32 * sb + 16 * sp), pf, O0, 0, 0, 0);
                        O1 = __builtin_amdgcn_mfma_f32_32x32x16_bf16(frag_tr_perm_x(L + HO_VT, TL, 32 + ql, 32 * sb + 16 * sp), pf, O1, 0, 0, 0); }
                }
            }
#pragma unroll
            for (int s = 0; s < 4; ++s) { const bf16x8 qf = frag_rm(L + HO_QS, 32 * tb + ql, s, hh);
                O0 = __builtin_amdgcn_mfma_f32_32x32x16_bf16(frag_tr_x(L + HO_ST, TL, ql, s), qf, O0, 0, 0, 0);
                O1 = __builtin_amdgcn_mfma_f32_32x32x16_bf16(frag_tr_x(L + HO_ST, TL, 32 + ql, s), qf, O1, 0, 0, 0); }
#pragma unroll
            for (int g = 0; g < 4; ++g) { LAS float* op = obuf + (32 * tb + ql) * 64 + 8 * g + 4 * hh;
                *(LAS f32x4*)op = (f32x4){O0[4 * g], O0[4 * g + 1], O0[4 * g + 2], O0[4 * g + 3]}; *(LAS f32x4*)(op + 32) = (f32x4){O1[4 * g], O1[4 * g + 1], O1[4 * g + 2], O1[4 * g + 3]}; }
        } else if (wave >= 4) {
            const int kb = wave & 1, vb = (wave >> 1) & 1;
#pragma unroll
            for (int g = 0; g < 4; ++g) { const f32x4 de = *(const LAS f32x4*)(dd + 32 * kb + 8 * g + 4 * hh);
                Sacc[4 * g] *= de.x; Sacc[4 * g + 1] *= de.y; Sacc[4 * g + 2] *= de.z; Sacc[4 * g + 3] *= de.w; }
#pragma unroll
            for (int s = 0; s < 4; ++s) Sacc = __builtin_amdgcn_mfma_f32_32x32x16_bf16(frag_tr_x(L + HO_KT, TL, 32 * kb + ql, s), frag_tr_x(L + HO_VT, TL, 32 * vb + ql, s), Sacc, 0, 0, 0);
        }
        LDS_BARRIER();
        scan_epilogue_r<0>(obuf, gcur, X.yb, X.ldy, row, Y_A + h * 64, ngv, t, c);
        if (wave >= 4) { const int kb = wave & 1, vb = (wave >> 1) & 1;
#pragma unroll
            for (int g = 0; g < 4; ++g) *(LAS unsigned long long*)(L + HO_ST + tr_c4(TL, 32 * vb + ql, kb, g)) = pack4(Sacc[4 * g], Sacc[4 * g + 1], Sacc[4 * g + 2], Sacc[4 * g + 3]);
        }
    }
    __syncthreads();
}

__device__ __forceinline__ void ret_unit(Frame& F, const MixCtx& X, int b, int h) {
    OPAQUE_TID();
    LAS unsigned char* L = F.lds + RING_OFF;
    LAS float* obuf = (LAS float*)(L + HO_OB);
    const int t = tid >> 3, c = tid & 7, ql = lane & 31, hh = lane >> 5;
    const TrLane TL = tr_lane(ql, hh);
    const float lg2 = __builtin_amdgcn_logf(1.f - __builtin_amdgcn_exp2f(-5.f - (float)h));
    const float* ng = X.a->in[I_RETN] + X.l * 256 + h * 64;
    float ngv[8];
#pragma unroll
    for (int e = 0; e < 8; ++e) ngv[e] = ng[8 * c + e];
    const f32x2* rope = (const f32x2*)(X.a->ws + WS_ROPE);
    for (int i = tid; i < 64 * GT_TR / 4; i += NTHR) ((LAS unsigned*)(L + HO_ST))[i] = 0u;
    for (int i = tid; i < 3 * 8192 / 4; i += NTHR) ((LAS unsigned*)(L + HO_QI))[i] = 0u;
    f32x16 Sacc;
#pragma unroll
    for (int i = 0; i < 16; ++i) Sacc[i] = 0.f;
    float dmask[16], dfull[16];
#pragma unroll
    for (int i = 0; i < 16; ++i) { const int kap = (i & 3) + 8 * (i >> 2) + 4 * hh; dmask[i] = kap <= ql ? __builtin_amdgcn_exp2f((float)(ql - kap) * lg2) : 0.f; dfull[i] = __builtin_amdgcn_exp2f((float)(32 + ql - kap) * lg2); }
    const float g64 = __builtin_amdgcn_exp2f(64.f * lg2), gq = __builtin_amdgcn_exp2f((float)(t + 1) * lg2), gk = __builtin_amdgcn_exp2f((float)(63 - t) * lg2);
    const bf16* base = X.proj + ((size_t)b * SEQ + t) * NMIX + h * 64 + 8 * c;
    const int i0 = 8 * (c & 1); const bool hi = (c & 2) != 0; const float sc = c >= 4 ? 0.17677669529663687f : 1.f;
    v4u rx = *(const GAS v4u*)(base + C_DQK), rv = *(const GAS v4u*)(base + C_DV), rg = *(const GAS v4u*)(base + C_DG);
    f32x2 cs[8];
#pragma unroll
    for (int e = 0; e < 8; ++e) cs[e] = rope[t * 16 + i0 + e];
    __syncthreads();
    for (int n = 0; n < NCHUNK; ++n) {
        const size_t row = (size_t)b * SEQ + n * CHUNK + t;
        {
          float x[8], p[8]; up8bf(rx, x);
#pragma unroll
          for (int e = 0; e < 8; ++e) p[e] = __shfl_xor(x[e], 2);
          float o[8], od[8];
#pragma unroll
          for (int e = 0; e < 8; ++e) { o[e] = (hi ? (p[e] * cs[e].y + x[e] * cs[e].x) : (x[e] * cs[e].x - p[e] * cs[e].y)) * sc; od[e] = o[e] * (c < 4 ? gq : gk); }
          if (c < 4) { st_rm(L + HO_QI, t, c, o); st_rm(L + HO_QS, t, c, od); }
          else { st_rm(L + HO_KI, t, c - 4, o); st_trT(L + HO_KT, t, c - 4, od); }
          float vv[8]; up8bf(rv, vv); st_trT(L + HO_VT, t, c, vv); }
        const v4u gcur = rg;
        if (n + 1 < NCHUNK) { const bf16* nb = base + (size_t)(n + 1) * CHUNK * NMIX; rx = *(const GAS v4u*)(nb + C_DQK); rv = *(const GAS v4u*)(nb + C_DV); rg = *(const GAS v4u*)(nb + C_DG);
#pragma unroll
            for (int e = 0; e < 8; ++e) cs[e] = rope[((n + 1) * CHUNK + t) * 16 + i0 + e]; }
        LDS_BARRIER();
        if (wave < 2) {
            const int tb = wave;
            f32x16 O0, O1;
#pragma unroll
            for (int i = 0; i < 16; ++i) { O0[i] = 0.f; O1[i] = 0.f; }
#pragma unroll
            for (int sb = 0; sb < 2; ++sb) {
                if (sb <= tb) {
                    f32x16 P;
#pragma unroll
                    for (int i = 0; i < 16; ++i) P[i] = 0.f;
#pragma unroll
                    for (int s = 0; s < 2; ++s) P = __builtin_amdgcn_mfma_f32_32x32x16_bf16(frag_rm(L + HO_KI, 32 * sb + ql, s, hh), frag_rm(L + HO_QI, 32 * tb + ql, s, hh), P, 0, 0, 0);
                    float w[16];
#pragma unroll
                    for (int i = 0; i < 16; ++i) w[i] = P[i] * (sb == tb ? dmask[i] : dfull[i]);
#pragma unroll
                    for (int sp = 0; sp < 2; ++sp) { const bf16x8 pf = pack8(w[8 * sp], w[8 * sp + 1], w[8 * sp + 2], w[8 * sp + 3], w[8 * sp + 4], w[8 * sp + 5], w[8 * sp + 6], w[8 * sp + 7]);
                        O0 = __builtin_amdgcn_mfma_f32_32x32x16_bf16(frag_tr_perm_x(L + HO_VT, TL, ql, 32 * sb + 16 * sp), pf, O0, 0, 0, 0);
                        O1 = __builtin_amdgcn_mfma_f32_32x32x16_bf16(frag_tr_perm_x(L + HO_VT, TL, 32 + ql, 32 * sb + 16 * sp), pf, O1, 0, 0, 0); }
                }
            }
#pragma unroll
            for (int s = 0; s < 2; ++s) { const bf16x8 qf = frag_rm(L + HO_QS, 32 * tb + ql, s, hh);
                O0 = __builtin_amdgcn_mfma_f32_32x32x16_bf16(frag_tr_x(L + HO_ST, TL, ql, s), qf, O0, 0, 0, 0);
                O1 = __builtin_amdgcn_mfma_f32_32x32x16_bf16(frag_tr_x(L + HO_ST, TL, 32 + ql, s), qf, O1, 0, 0, 0); }
#pragma unroll
            for (int g = 0; g < 4; ++g) { LAS float* op = obuf + (32 * tb + ql) * 64 + 8 * g + 4 * hh;
                *(LAS f32x4*)op = (f32x4){O0[4 * g], O0[4 * g + 1], O0[4 * g + 2], O0[4 * g + 3]}; *(LAS f32x4*)(op + 32) = (f32x4){O1[4 * g], O1[4 * g + 1], O1[4 * g + 2], O1[4 * g + 3]}; }
        } else if (wave == 4 || wave == 5) {
            const int vb = wave & 1;
#pragma unroll
            for (int i = 0; i < 16; ++i) Sacc[i] *= g64;
#pragma unroll
            for (int s = 0; s < 4; ++s) Sacc = __builtin_amdgcn_mfma_f32_32x32x16_bf16(frag_tr_x(L + HO_KT, TL, ql, s), frag_tr_x(L + HO_VT, TL, 32 * vb + ql, s), Sacc, 0, 0, 0);
        }
        LDS_BARRIER();
        scan_epilogue_r<1>(obuf, gcur, X.yb, X.ldy, row, Y_D + h * 64, ngv, t, c);
        if (wave == 4 || wave == 5) { const int vb = wave & 1;
#pragma unroll
            for (int g = 0; g < 4; ++g) *(LAS unsigned long long*)(L + HO_ST + tr_c4(TL, 32 * vb + ql, 0, g)) = pack4(Sacc[4 * g], Sacc[4 * g + 1], Sacc[4 * g + 2], Sacc[4 * g + 3]);
        }
    }
    __syncthreads();
}

constexpr int GDN_PREP_UNITS = 256;
constexpr int MIX_UNITS = 704 + GDN_PREP_UNITS;
#ifndef DRY_LO
#define DRY_LO 0
#define DRY_HI 64
#endif
#ifndef DRY_EXP
#define DRY_EXP 0
#endif
__device__ __forceinline__ void mixers_phase(Frame& F, const MixCtx& X0) {
    OPAQUE_TID();
    gu32* head = F.ctl + CW_QUEUE + 64 * X0.l + (X0.yb == X0.proj ? 0 : 32);
    constexpr int NDRY = DRY_EXP == 1 ? 512 : DRY_EXP == 2 ? 192 : 0;
    for (;;) {
        __syncthreads();
        if (tid == 0) F.MISC[16] = __hip_atomic_fetch_add(head, 1u, RLX_AGENT);
        __syncthreads();
        int u = __builtin_amdgcn_readfirstlane((int)F.MISC[16]);
        if (u >= MIX_UNITS + NDRY + (X0.l + 1 < DEPTH ? CONV_UNITS : 0)) break;
        if (u >= MIX_UNITS + NDRY) { convert_unit(F, *X0.a, X0.l + 1, u - MIX_UNITS - NDRY); continue; }
        MixCtx X = X0;
        if (DRY_EXP == 3 && X0.yb != X0.proj) { u += DRY_LO; if (u >= DRY_HI) break; }
        if (DRY_EXP == 1) { if (u >= 192 && u < 192 + 512) { X.yb = (bf16*)X0.a->out + (size_t)M * DM; X.ldy = DM; } else if (u >= 192 + 512) u -= 512; }
        if (DRY_EXP == 2) { if (u < 192) { X.yb = (bf16*)X0.a->out + (size_t)M * DM; X.ldy = DM; } else u -= 192; }
        if (u < GDN_PREP_UNITS) { gdn_prep_unit(F, X, u >> 4, (u >> 2) & 3, u & 3); continue; }
        u -= GDN_PREP_UNITS;
        if (u < 64) gdn_main(F, X, u >> 2, u & 3);
        else if (u < 128) { if (HGRN_CHUNKED) hgrn_unit(F, X, (u - 64) >> 2, (u - 64) & 3); else scan_hgrn2(F, X, (u - 64) >> 2, (u - 64) & 3); }
        else if (u < 192) { if (RET_CHUNKED) ret_unit(F, X, (u - 128) >> 2, (u - 128) & 3); else scan_retention(F, X, (u - 128) >> 2, (u - 128) & 3); }
        else { const int a = u - 192, bh = a & 63; sb_unit(F, X, bh >> 2, bh & 3, 7 - (a >> 6)); }
    }
}

__device__ __forceinline__ void final_norm(Frame& F, float* x, const float* g) {
    OPAQUE_TID();
    const int gw = F.vcu * NWAVES + wave, NGW = F.G * NWAVES;
    f32x4 gv[4];
#pragma unroll
    for (int j = 0; j < 4; ++j) gv[j] = ((const f32x4*)g)[lane + 64 * j];
    for (int m = gw; m < M; m += NGW) {
        GAS f32x4* xr = (GAS f32x4*)(x + (size_t)m * DM) + lane;
        f32x4 v[4]; float s = 0.f;
#pragma unroll
        for (int j = 0; j < 4; ++j) { v[j] = xr[64 * j]; s += (v[j].x * v[j].x + v[j].y * v[j].y) + (v[j].z * v[j].z + v[j].w * v[j].w); }
        s = wave_sum(s);
        const float rstd = 1.f / sqrtf(s * (1.f / DM) + EPS);
#pragma unroll
        for (int j = 0; j < 4; ++j) xr[64 * j] = v[j] * rstd * gv[j];
    }
}

constexpr int PH_PRO = 0, PH_PER_J = 6, PH_FINAL = 1 + 8 * PH_PER_J, NPH = PH_FINAL + 1;
__global__ void __launch_bounds__(NTHR, 2) fwd_kernel(Args args) {
    extern __shared__ __attribute__((aligned(16))) unsigned char lds[];
    Frame F;
    F.lds = (LAS unsigned char*)lds;
    F.MISC = (volatile LAS unsigned*)(F.lds + MISC_OFF);
    F.G = gridDim.x; { const int bx = blockIdx.x; F.vcu = (F.G % 8 == 0) ? (bx % 8) * (F.G / 8) + bx / 8 : bx; }
    unsigned char* ws = args.ws;
    F.ctl = (gu32*)(ws + WS_CTL);
    for (int u = threadIdx.x; u < (LDS_BYTES - LDSCTL_OFF) / 4; u += NTHR) ((LAS unsigned*)(F.lds + LDSCTL_OFF))[u] = 0u;
    __syncthreads();
    const int lo = args.ph_lo, hi = args.ph_hi;
    const bool multi = (hi - lo) > 1;
    XcdBarrier bar; bar.bar = (unsigned*)(F.ctl + CW_BAR); bar.x = 0; bar.st = nullptr;
    if (multi) bar = xcd_barrier_post((unsigned*)(F.ctl + CW_BAR), F.MISC + 8);
#define IN(k) (lo <= (k) && (k) < hi)
#define GRID_BAR() do { if (multi) xcd_barrier(bar); } while (0)

    bf16* xb = (bf16*)(ws + WS_XB);
    bf16* big = (bf16*)(ws + WS_BIG);
    float* ssq = (float*)(ws + WS_SSQ);

#if DIAG
    unsigned long long tacc[6] = {0, 0, 0, 0, 0, 0}; unsigned long long tst = __builtin_amdgcn_s_memrealtime();
#define DSTAMP(k) do { const unsigned long long tn = __builtin_amdgcn_s_memrealtime(); tacc[k] += tn - tst; tst = tn; } while (0)
#else
#define DSTAMP(k) do {} while (0)
#endif
    if (multi && threadIdx.x == 0 && (bar.x != (blockIdx.x & 7u) || F.G != 256)) __hip_atomic_store(F.ctl + CW_XMAP, 1u, RLX_AGENT);
    bool loc = false;
    if (IN(PH_PRO)) { p0_prologue(F, args); GRID_BAR(); DSTAMP(0);
        if (multi) { if (threadIdx.x == 0) F.MISC[24] = __hip_atomic_load(F.ctl + CW_XMAP, RLX_AGENT); __syncthreads(); loc = __builtin_amdgcn_readfirstlane((int)F.MISC[24]) == 0; } }
#define SEAM_BAR() do { if (multi) { if (loc) xcd_local_barrier(bar); else xcd_barrier(bar); } } while (0)

    const bool fused_fin = multi && F.G == 256;
    for (int j = 0; j < 8; ++j) {
        const int l = j >> 1, odd = j & 1, pb = 1 + j * PH_PER_J;
        const unsigned char* wl = ws + WS_W + (size_t)l * WL_BYTES;
        if (IN(pb + 0)) {
            pg8::Gemm g{xb, (const bf16*)(wl + (odd ? WL_FI2 : WL_FI1)), M, NFI, DM, DM}; pg8::StaticOrder S; S.init(M, NFI, F.G, (int)blockIdx.x);
            pg8::EpiSwiglu E{big, DFF, ssq, 1.f / DM, (LAS float*)(F.lds + RS_OFF), -1};
            pg8::gemm_phase<pg8::EpiSwiglu, pg8::StaticOrder, true, true>(F.lds + RING_OFF, g, S, E);
            SEAM_BAR(); DSTAMP(1);
        }
        if (IN(pb + 1)) {
            pg8::Gemm g{big, (const bf16*)(wl + (odd ? WL_FO2 : WL_FO1)), M, DM, DFF, DFF}; pg8::StaticOrder S; S.init(M, DM, F.G, (int)blockIdx.x);
            if (j == 7 && fused_fin) {
                pg8::EpiFinal E{args.out, xb, ssq, (unsigned*)(F.ctl + CW_FIN), args.in[I_FN], DM, 0.5f, (unsigned*)(F.ctl + CW_TMO)};
                pg8::gemm_phase<pg8::EpiFinal, pg8::StaticOrder, true, true>(F.lds + RING_OFF, g, S, E);
            } else {
                pg8::EpiResid E{j == 7 ? args.out : nullptr, xb, ssq, DM, 0.5f, odd ? nullptr : (const bf16*)(wl + WL_MI) + (size_t)NMIX_G * DM, (float*)((unsigned char*)args.out + OUT_ABP)};
                pg8::gemm_phase<pg8::EpiResid, pg8::StaticOrder, true, true>(F.lds + RING_OFF, g, S, E);
                SEAM_BAR(); DSTAMP(2);
            }
        }
        if (!odd) {
            if (IN(pb + 2)) {
                pg8::Gemm g{xb, (const bf16*)(wl + WL_MI), M, NMIX_G, DM, DM}; pg8::StaticOrder S; S.init(M, NMIX_G, F.G, (int)blockIdx.x);
                pg8::EpiProj E{big, NMIX, ssq, 1.f / DM, (LAS float*)(F.lds + RS_OFF), -1};
                pg8::gemm_phase<pg8::EpiProj, pg8::StaticOrder, true, true>(F.lds + RING_OFF, g, S, E);
                GRID_BAR(); DSTAMP(3);
            }
            if (IN(pb + 3)) {
#if DRY_EXP == 3
                { MixCtx Xd{big, l, &args, (bf16*)args.out + (size_t)M * DM, DM}; mixers_phase(F, Xd); GRID_BAR(); }
#endif
                MixCtx X{big, l, &args, big, NMIX};
                mixers_phase(F, X);
                GRID_BAR(); DSTAMP(4);
            }
            if (IN(pb + 4)) {
                pg8::Gemm g{big, (const bf16*)(wl + WL_MO), M, DM, DM, NMIX}; pg8::StaticOrder S; S.init(M, DM, F.G, (int)blockIdx.x);
                pg8::EpiResid E{nullptr, xb, ssq, DM, 1.f, nullptr, nullptr};
                pg8::gemm_phase<pg8::EpiResid, pg8::StaticOrder, true, true>(F.lds + RING_OFF, g, S, E);
                SEAM_BAR(); DSTAMP(5);
            }
        }
    }
    if (IN(PH_FINAL) && !fused_fin) final_norm(F, args.out, args.in[I_FN]);
#if DIAG
    {
        GRID_BAR();
        if (blockIdx.x == 0 && threadIdx.x == 0) { __hip_atomic_store(F.ctl + 16, (unsigned)(tacc[DIAG_A] / 100), RLX_AGENT); __hip_atomic_store(F.ctl + 17, (unsigned)(tacc[DIAG_B] / 100), RLX_AGENT); }
        GRID_BAR();
        const float va = (float)__hip_atomic_load(F.ctl + 16, RLX_AGENT), vb = (float)__hip_atomic_load(F.ctl + 17, RLX_AGENT);
        for (size_t i = (size_t)blockIdx.x * NTHR + threadIdx.x; i < (size_t)M * DM; i += (size_t)gridDim.x * NTHR) args.out[i] = (i == 0) ? vb : va;
    }
#endif
#undef IN
#undef GRID_BAR
#undef SEAM_BAR
}

#ifndef MK_PER_PHASE
#define MK_PER_PHASE 0
#endif
extern "C" void kernel_launch(void* const* d_in, const int* in_sizes, int n_in, void* d_out, int out_size, void* d_ws, size_t ws_size, hipStream_t stream) {
    static int grid = 0;
    if (grid == 0) {
        if (n_in != 19 || in_sizes[0] != M * DM || out_size != M * DM || ws_size < WS_END) {
            fprintf(stderr, "kernel_launch: built for 19 inputs, x/out of %d floats, >= %zu bytes of workspace; got n_in %d, in0 %d, out %d, ws %zu; nothing launched\n", M * DM, (size_t)WS_END, n_in, n_in > 0 ? in_sizes[0] : -1, out_size, ws_size);
            grid = -1; return; }
        int dev = 0, cus = 0, per_cu = 0;
        if (hipGetDevice(&dev) != hipSuccess || hipDeviceGetAttribute(&cus, hipDeviceAttributeMultiprocessorCount, dev) != hipSuccess) { fprintf(stderr, "kernel_launch: device query failed\n"); grid = -1; return; }
        if (hipFuncSetAttribute((const void*)fwd_kernel, hipFuncAttributeMaxDynamicSharedMemorySize, LDS_BYTES) != hipSuccess) { fprintf(stderr, "kernel_launch: hipFuncSetAttribute failed\n"); grid = -1; return; }
        if (hipOccupancyMaxActiveBlocksPerMultiprocessor(&per_cu, (const void*)fwd_kernel, NTHR, LDS_BYTES) != hipSuccess || per_cu < 1)
            fprintf(stderr, "kernel_launch: note: occupancy query reports %d workgroups per CU\n", per_cu);
        (void)hipGetLastError();
        grid = cus;
    }
    if (grid < 0) return;
    if (hipMemsetAsync((char*)d_ws + WS_CTL, 0, CTL_ZERO_BYTES, stream) != hipSuccess) { fprintf(stderr, "kernel_launch: hipMemsetAsync failed\n"); return; }
    Args a{};
    for (int i = 0; i < 19; ++i) a.in[i] = (const float*)d_in[i];
    a.out = (float*)d_out; a.ws = (unsigned char*)d_ws;
#if MK_PER_PHASE
    for (int p = 0; p < NPH; ++p) {
        if (p >= 1 && p < PH_FINAL) { const int j = (p - 1) / PH_PER_J, k = (p - 1) % PH_PER_J; if (k == 5 || ((j & 1) && k >= 2)) continue; }
        a.ph_lo = p; a.ph_hi = p + 1;
        hipLaunchKernelGGL(fwd_kernel, dim3(grid), dim3(NTHR), LDS_BYTES, stream, a);
    }
#else
    a.ph_lo = 0; a.ph_hi = NPH;
    hipLaunchKernelGGL(fwd_kernel, dim3(grid), dim3(NTHR), LDS_BYTES, stream, a);
#endif
    const hipError_t le = hipPeekAtLastError();
    if (le != hipSuccess) fprintf(stderr, "kernel_launch: launch failed: %s\n", hipGetErrorName(le));
}
```
